# Optimizing an MI355X kernel written in HIP

```python
import jax, jax.numpy as jnp
from jax import lax
import numpy as np

D_MODEL = 1024
BATCH = 8
SEQ = 8192
DEPTH = 4

GRID_W = 64
CTX_LEN = 256
D_MIX = D_MODEL
HEAD_DIM = 64
NA_W = D_MIX // 2
NA_HEADS = NA_W // HEAD_DIM
NA_KH = 8
NA_KW = 16
LRU_W = D_MIX // 4
LRU_HEADS = 4
LRU_HD = LRU_W // LRU_HEADS
LRU_CONV = 4
LRU_C = 8.0
FNO_W = D_MIX - NA_W - LRU_W
FNO_GROUPS = 4
FNO_GD = FNO_W // FNO_GROUPS
IN_COLS = 3 * NA_W + 2 * LRU_W + FNO_W
D_FF = ((8 * D_MODEL // 3 + 255) // 256) * 256
N_SUB = 3
N_MOD = 3 * N_SUB
MACARON = 0.5
ALPHA = (2 * DEPTH) ** 0.25
BETA = (8 * DEPTH) ** -0.25
LN_EPS = 1e-5

kernel_name = "hymba_style_na_rglru_fourier_macaron_deepnorm_dit"


def layer_norm(z, g, b):
    mu = jnp.mean(z, axis=-1, keepdims=True)
    var = jnp.mean(jnp.square(z - mu), axis=-1, keepdims=True)
    return (z - mu) * lax.rsqrt(var + LN_EPS) * g + b


def residual_post_norm(x, y, g, b):
    z = ALPHA * x.astype(jnp.float32) + y.astype(jnp.float32)
    return layer_norm(z, g.astype(jnp.float32), b.astype(jnp.float32)).astype(x.dtype)


def modulate(xs, m, j):
    return xs * (1 + m[3 * j + 1]) + m[3 * j]


def swiglu(h, wg, wu, wd):
    return (jax.nn.silu(h @ wg) * (h @ wu)) @ wd


def ffn_sublayer(xs, m, j, wg, wu, wd, g, b):
    y = MACARON * swiglu(modulate(xs, m, j), wg, wu, wd)
    return residual_post_norm(xs, m[3 * j + 2] * y, g, b)


def split_heads(t):
    bsz, n, w = t.shape
    return t.reshape(bsz, n, w // HEAD_DIM, HEAD_DIM).transpose(0, 2, 1, 3)


def merge_heads(t):
    bsz, h, n, d = t.shape
    return t.transpose(0, 2, 1, 3).reshape(bsz, n, h * d)


def context_attention(qc, kc, vc):
    s = jnp.einsum('bhqd,bhkd->bhqk', qc, kc).astype(jnp.float32)
    p = jax.nn.softmax(s, axis=-1).astype(vc.dtype)
    return jnp.einsum('bhqk,bhkd->bhqd', p, vc)


def neighbourhood_attention(q, k, v, kc, vc, rpb):
    bsz, nh, s_len, hd = q.shape
    rows = s_len // GRID_W
    kh = min(NA_KH, rows)
    qg = q.reshape(bsz, nh, rows, GRID_W, hd)
    kg = k.reshape(bsz, nh, rows, GRID_W, hd)
    vg = v.reshape(bsz, nh, rows, GRID_W, hd)
    col0 = np.clip(np.arange(GRID_W) - NA_KW // 2, 0, GRID_W - NA_KW)
    cols = col0[:, None] + np.arange(NA_KW)[None, :]
    dc_idx = cols - np.arange(GRID_W)[:, None] + (NA_KW - 1)
    n_loc = kh * NA_KW

    def row_fn(r):
        rs = jnp.clip(r - kh // 2, 0, rows - kh)
        kb = lax.dynamic_slice_in_dim(kg, rs, kh, axis=2)
        vb = lax.dynamic_slice_in_dim(vg, rs, kh, axis=2)
        kw = kb[:, :, :, cols, :]
        vw = vb[:, :, :, cols, :]
        qr = lax.dynamic_index_in_dim(qg, r, axis=2, keepdims=False)
        s_loc = jnp.einsum('bhqd,bhiqjd->bhqij', qr, kw).astype(jnp.float32)
        dr_idx = rs + jnp.arange(kh) - r + (NA_KH - 1)
        bias = rpb[:, dr_idx][:, :, dc_idx].transpose(0, 2, 1, 3)
        s_loc = s_loc + bias[None].astype(jnp.float32)
        s_ctx = jnp.einsum('bhqd,bhkd->bhqk', qr, kc).astype(jnp.float32)
        s = jnp.concatenate([s_loc.reshape(bsz, nh, GRID_W, n_loc), s_ctx], axis=-1)
        p = jax.nn.softmax(s, axis=-1)
        p_loc = p[..., :n_loc].reshape(bsz, nh, GRID_W, kh, NA_KW).astype(vw.dtype)
        p_ctx = p[..., n_loc:].astype(vc.dtype)
        return (jnp.einsum('bhqij,bhiqjd->bhqd', p_loc, vw)
                + jnp.einsum('bhqk,bhkd->bhqd', p_ctx, vc))

    out = lax.map(row_fn, jnp.arange(rows))
    return out.transpose(1, 2, 0, 3, 4).reshape(bsz, nh, s_len, hd)


def conv_centred(x, w, b):
    n = x.shape[1]
    left = LRU_CONV // 2
    xp = jnp.pad(x, ((0, 0), (left, LRU_CONV - 1 - left), (0, 0)))
    y = xp[:, 0:n] * w[0]
    for t in range(1, LRU_CONV):
        y = y + xp[:, t:t + n] * w[t]
    return y + b


def rglru_coeffs(x, wa, ba, wx, bx, lam):
    bsz, n, _ = x.shape
    xb = x.reshape(bsz, n, LRU_HEADS, LRU_HD)
    r = jax.nn.sigmoid(jnp.einsum('bnhc,hcd->bnhd', xb, wa).reshape(bsz, n, LRU_W) + ba)
    i = jax.nn.sigmoid(jnp.einsum('bnhc,hcd->bnhd', xb, wx).reshape(bsz, n, LRU_W) + bx)
    log_a = -LRU_C * r * jax.nn.softplus(-lam)
    a = jnp.exp(log_a)
    bterm = jnp.sqrt(-jnp.expm1(2.0 * log_a)) * (i * x)
    return a, bterm


def linear_scan(a, b, h0, reverse):
    def combine(e1, e2):
        a1, b1 = e1
        a2, b2 = e2
        return a1 * a2, a2 * b1 + b2
    a_cum, b_cum = lax.associative_scan(combine, (a, b), axis=1, reverse=reverse)
    return b_cum + a_cum * h0[:, None, :]


def rglru_bidirectional(x_lat, x_ctx, wa, ba, wx, bx, lam):
    outs_lat, outs_ctx = [], []
    for d, reverse in enumerate((False, True)):
        f32 = jnp.float32
        pa = (wa[d].astype(f32), ba[d].astype(f32), wx[d].astype(f32), bx[d].astype(f32), lam[d].astype(f32))
        a_c, b_c = rglru_coeffs(x_ctx, *pa)
        h_c = linear_scan(a_c, b_c, jnp.zeros((x_ctx.shape[0], LRU_W), f32), reverse)
        h_end = h_c[:, 0] if reverse else h_c[:, -1]
        a_l, b_l = rglru_coeffs(x_lat, *pa)
        outs_lat.append(linear_scan(a_l, b_l, h_end, reverse))
        outs_ctx.append(h_c)
    return outs_lat[0] + outs_lat[1], outs_ctx[0] + outs_ctx[1]


def fourier_mix(f, fw):
    bsz, n, _ = f.shape
    fb = f.astype(jnp.float32).reshape(bsz, n, FNO_GROUPS, FNO_GD)
    y = jnp.fft.fft2(fb, axes=(1, 3), norm='ortho').real
    y = jnp.einsum('bngc,gcd->bngd', y, fw.astype(jnp.float32))
    return y.reshape(bsz, n, FNO_W)


def hybrid_mixer(h_lat, h_ctx, w_in, w_out, rpb, conv_w, conv_b, wa, ba, wx, bx, lam, fw, need_ctx):
    dt = h_lat.dtype
    cuts = [NA_W, 2 * NA_W, 3 * NA_W, 3 * NA_W + LRU_W, 3 * NA_W + 2 * LRU_W]
    q, k, v, xr, gr, f = jnp.split(h_lat @ w_in, cuts, axis=-1)
    qc, kc, vc, xrc, grc, fc = jnp.split(h_ctx @ w_in, cuts, axis=-1)
    scale = HEAD_DIM ** -0.5
    kch, vch = split_heads(kc), split_heads(vc)
    na_lat = merge_heads(neighbourhood_attention(split_heads(q) * scale, split_heads(k), split_heads(v), kch, vch, rpb))
    xl = conv_centred(xr, conv_w, conv_b).astype(jnp.float32)
    xc = conv_centred(xrc, conv_w, conv_b).astype(jnp.float32)
    hl, hc = rglru_bidirectional(xl, xc, wa, ba, wx, bx, lam)
    lru_lat = (hl * jax.nn.gelu(gr.astype(jnp.float32))).astype(dt)
    fno_lat = fourier_mix(f, fw).astype(dt)
    y_lat = jnp.concatenate([na_lat, lru_lat, fno_lat], axis=-1) @ w_out
    if not need_ctx:
        return y_lat, None
    na_ctx = merge_heads(context_attention(split_heads(qc) * scale, kch, vch))
    lru_ctx = (hc * jax.nn.gelu(grc.astype(jnp.float32))).astype(dt)
    fno_ctx = fourier_mix(fc, fw).astype(dt)
    y_ctx = jnp.concatenate([na_ctx, lru_ctx, fno_ctx], axis=-1) @ w_out
    return y_lat, y_ctx


def setup_inputs(seed: int = 0) -> dict:
    key = jax.random.key(seed)
    ks = jax.random.split(key, 32)
    f32 = jnp.float32

    def nrm(k, shape, s):
        return s * jax.random.normal(k, shape, f32)

    a0 = jax.random.uniform(ks[22], (DEPTH, 2, LRU_W), f32, 0.9, 0.999)
    s0 = a0 ** (1.0 / LRU_C)
    lru_lambda = jnp.log(s0) - jnp.log1p(-s0)
    return {
        "x": nrm(ks[0], (BATCH, SEQ, D_MODEL), 1.0),
        "c": nrm(ks[1], (BATCH, D_MODEL), 1.0),
        "ctx": nrm(ks[2], (BATCH, CTX_LEN, D_MODEL), 1.0),
        "c_ctx": nrm(ks[3], (D_MODEL,), 1.0),
        "w_ada": nrm(ks[4], (DEPTH, D_MODEL, N_MOD * D_MODEL), 0.5 * D_MODEL ** -0.5),
        "b_ada": nrm(ks[5], (DEPTH, N_MOD * D_MODEL), 0.01),
        "ln_g": 1.0 + nrm(ks[6], (DEPTH, N_SUB, D_MODEL), 0.02),
        "ln_b": nrm(ks[7], (DEPTH, N_SUB, D_MODEL), 0.02),
        "ff1_gate": nrm(ks[8], (DEPTH, D_MODEL, D_FF), D_MODEL ** -0.5),
        "ff1_up": nrm(ks[9], (DEPTH, D_MODEL, D_FF), D_MODEL ** -0.5),
        "ff1_down": nrm(ks[10], (DEPTH, D_FF, D_MODEL), BETA * D_FF ** -0.5),
        "ff2_gate": nrm(ks[11], (DEPTH, D_MODEL, D_FF), D_MODEL ** -0.5),
        "ff2_up": nrm(ks[12], (DEPTH, D_MODEL, D_FF), D_MODEL ** -0.5),
        "ff2_down": nrm(ks[13], (DEPTH, D_FF, D_MODEL), BETA * D_FF ** -0.5),
        "w_in": nrm(ks[14], (DEPTH, D_MODEL, IN_COLS), D_MODEL ** -0.5),
        "w_out": nrm(ks[15], (DEPTH, D_MIX, D_MODEL), BETA * D_MIX ** -0.5),
        "na_rpb": nrm(ks[16], (DEPTH, NA_HEADS, 2 * NA_KH - 1, 2 * NA_KW - 1), 0.02),
        "lru_conv_w": nrm(ks[17], (DEPTH, LRU_CONV, LRU_W), LRU_CONV ** -0.5),
        "lru_conv_b": nrm(ks[18], (DEPTH, LRU_W), 0.01),
        "lru_wa": nrm(ks[19], (DEPTH, 2, LRU_HEADS, LRU_HD, LRU_HD), LRU_HD ** -0.5),
        "lru_ba": nrm(ks[20], (DEPTH, 2, LRU_W), 0.01),
        "lru_wx": nrm(ks[21], (DEPTH, 2, LRU_HEADS, LRU_HD, LRU_HD), LRU_HD ** -0.5),
        "lru_bx": nrm(ks[23], (DEPTH, 2, LRU_W), 0.01),
        "lru_lambda": lru_lambda,
        "fno_w": nrm(ks[24], (DEPTH, FNO_GROUPS, FNO_GD, FNO_GD), FNO_GD ** -0.5),
    }


def reference(x, c, ctx, c_ctx, w_ada, b_ada, ln_g, ln_b, ff1_gate, ff1_up, ff1_down, ff2_gate, ff2_up, ff2_down,
              w_in, w_out, na_rpb, lru_conv_w, lru_conv_b, lru_wa, lru_ba, lru_wx, lru_bx, lru_lambda, fno_w):
    bsz = x.shape[0]
    x_lat, x_ctx = x, ctx
    for l in range(DEPTH):
        last = l == DEPTH - 1
        m_lat = (jax.nn.silu(c) @ w_ada[l] + b_ada[l]).reshape(bsz, N_MOD, D_MODEL).transpose(1, 0, 2)[:, :, None, :]
        m_ctx = (jax.nn.silu(c_ctx) @ w_ada[l] + b_ada[l]).reshape(N_MOD, D_MODEL)
        x_lat = ffn_sublayer(x_lat, m_lat, 0, ff1_gate[l], ff1_up[l], ff1_down[l], ln_g[l, 0], ln_b[l, 0])
        x_ctx = ffn_sublayer(x_ctx, m_ctx, 0, ff1_gate[l], ff1_up[l], ff1_down[l], ln_g[l, 0], ln_b[l, 0])
        y_lat, y_ctx = hybrid_mixer(modulate(x_lat, m_lat, 1), modulate(x_ctx, m_ctx, 1),
                                    w_in[l], w_out[l], na_rpb[l], lru_conv_w[l], lru_conv_b[l],
                                    lru_wa[l], lru_ba[l], lru_wx[l], lru_bx[l], lru_lambda[l], fno_w[l],
                                    not last)
        x_lat = residual_post_norm(x_lat, m_lat[5] * y_lat, ln_g[l, 1], ln_b[l, 1])
        x_lat = ffn_sublayer(x_lat, m_lat, 2, ff2_gate[l], ff2_up[l], ff2_down[l], ln_g[l, 2], ln_b[l, 2])
        if not last:
            x_ctx = residual_post_norm(x_ctx, m_ctx[5] * y_ctx, ln_g[l, 1], ln_b[l, 1])
            x_ctx = ffn_sublayer(x_ctx, m_ctx, 2, ff2_gate[l], ff2_up[l], ff2_down[l], ln_g[l, 2], ln_b[l, 2])
    return x_lat
```

```cpp
#include <hip/hip_runtime.h>
#include <hip/hip_cooperative_groups.h>
#include <cstdio>
namespace cg = cooperative_groups;

#define LAS __attribute__((address_space(3)))
typedef unsigned short u16;
typedef short bf16x8 __attribute__((ext_vector_type(8)));
typedef float f32x4 __attribute__((ext_vector_type(4)));
typedef unsigned u32x4 __attribute__((ext_vector_type(4)));
typedef unsigned u32x2 __attribute__((ext_vector_type(2)));
typedef _Float16 h16x4 __attribute__((ext_vector_type(4)));
typedef _Float16 h16x8 __attribute__((ext_vector_type(8)));
typedef float f32x8 __attribute__((ext_vector_type(8)));

constexpr int DM = 1024, NB = 8, SEQ = 8192, DEPTH = 4, CTXL = 256;
constexpr int TL = NB * SEQ, TC = NB * CTXL, TT = TL + TC;
constexpr int DFF = 2816, NIN = 2304, KOUT = 1280, NMOD = 9216;
constexpr float ALPHA = 1.681792830507429f;
constexpr float LN_EPS = 1e-5f;
constexpr int NTHREADS = 512;
constexpr int LDS_BYTES = 151552;

constexpr size_t OFF_H    = 0;
constexpr size_t OFF_P    = 0;
constexpr size_t OFF_VT   = (size_t)TT * NIN * 2;
constexpr size_t OFF_O    = (size_t)TT * DFF * 2;
constexpr size_t OFF_FT   = OFF_O + (size_t)TT * KOUT * 2;
constexpr size_t OFF_FTC  = OFF_FT + (size_t)NB * 256 * SEQ * 2;
constexpr size_t OFF_W    = OFF_FTC + (size_t)NB * 256 * CTXL * 2;
constexpr size_t W_GU1 = 0, W_D1 = 5767168, W_GU2 = 8650752, W_D2 = 14417920, W_IN = 17301504, W_OUT = 19660800, W_LAYER = 20971520;
constexpr size_t OFF_DFT  = OFF_W + W_LAYER * 2 * DEPTH;
constexpr size_t OFF_GE   = OFF_DFT + (size_t)8192 * 4096 * 2;
constexpr size_t OFF_GO   = OFF_GE + (size_t)NB * 256 * 4096 * 2;
constexpr size_t OFF_DFTC = OFF_DFT + (size_t)8192 * 8192 * 2;
constexpr size_t OFF_XC   = OFF_DFTC + (size_t)256 * 256 * 2;
constexpr size_t OFF_ST   = OFF_XC;
constexpr size_t OFF_ID   = OFF_XC + (size_t)TT * 8;
constexpr size_t OFF_MOD  = OFF_XC + (size_t)TC * DM * 4;
constexpr size_t OFF_LRU  = OFF_MOD + (size_t)DEPTH * 9 * NMOD * 4;
constexpr size_t OFF_CAR  = OFF_LRU + (size_t)NB * 264 * 2 * 256 * 8;
constexpr size_t OFF_LW   = OFF_CAR + (size_t)NB * 264 * 2 * 256 * 4;
constexpr size_t OFF_X16  = OFF_LW + (size_t)DEPTH * 16 * 4096 * 2;
constexpr size_t OFF_BAR  = OFF_X16 + (size_t)TT * DM * 2;
constexpr int XCD_BAR_WORDS = 3456;
constexpr size_t WS_END   = OFF_BAR + (size_t)XCD_BAR_WORDS * 4;
constexpr int VTP = SEQ + 64;
constexpr size_t OFF_VTC = OFF_XC + (size_t)(1 << 20);
static_assert((size_t)NB * 8 * 64 * VTP * 2 <= (size_t)TT * 512 * 2, "padded V^T must fit behind P");
static_assert((size_t)TT * 8 + 2 * DM * 4 <= (size_t)(1 << 20) && (size_t)(1 << 20) + (size_t)NB * 8 * 64 * CTXL * 2 <= (size_t)TC * DM * 4, "spare region layout");

struct Params {
    const float* in[25];
    float* out;
    unsigned char* ws;
};

typedef const __attribute__((address_space(4))) Params* KParamsPtr;
#if defined(__HIP_DEVICE_COMPILE__)
__device__ __forceinline__ Params kparams() { KParamsPtr k = (KParamsPtr)__builtin_amdgcn_kernarg_segment_ptr(); asm volatile("" : "+s"(k)); Params r; for (int i = 0; i < 25; ++i) r.in[i] = k->in[i]; r.out = k->out; r.ws = k->ws; return r; }
#else
__device__ __forceinline__ Params kparams() { return Params{}; }
#endif
__device__ __forceinline__ u16 f2bf(float f) { unsigned u = __float_as_uint(f); u += 0x7FFFu + ((u >> 16) & 1u); return (u16)(u >> 16); }
__device__ __forceinline__ float bf2f(u16 b) { return __uint_as_float(((unsigned)b) << 16); }
__device__ __forceinline__ unsigned pk_bf16(float lo, float hi) { unsigned r; asm volatile("v_cvt_pk_bf16_f32 %0, %1, %2" : "=v"(r) : "v"(lo), "v"(hi)); return r; }
__device__ __forceinline__ int opaque_tid() { int t = threadIdx.x; asm volatile("" : "+v"(t)); return t; }
__device__ __forceinline__ float silu_f(float v) { return v * __builtin_amdgcn_rcpf(1.f + __expf(-v)); }
__device__ __forceinline__ float sigmoid_f(float v) { return __builtin_amdgcn_rcpf(1.f + __expf(-v)); }
__device__ __forceinline__ float gelu_tanh(float x) {
    const float w = x * (2.3022081986f + 0.1029432396f * x * x);
    return x - x * __builtin_amdgcn_rcpf(1.f + __builtin_amdgcn_exp2f(w)); }

namespace pg8 {
constexpr int BM = 256, BK = 64, HALF = 128, HTB = HALF * BK * 2, NXCD = 8, WGM = 8;
__device__ __forceinline__ int lds_byte(int r, int c) { const int st = (r >> 4) * 2 + (c >> 5), rr = r & 15, cc = c & 31, ob = rr * 64 + cc * 2; return st * 1024 + (ob ^ (((ob >> 9) & 1) << 5)); }
__device__ __forceinline__ void stage_rc(int b, int& R, int& C) { const int st = b / 1024, sb = b % 1024, swz = sb ^ (((sb >> 9) & 1) << 5); R = (st >> 1) * 16 + swz / 64; C = (st & 1) * 32 + (swz % 64) / 2; }
__device__ __forceinline__ int perm32(int rho) { const int n = rho >> 4, i = rho & 15; return 8 * (i >> 2) + 4 * n + (i & 3); }
struct Unit { int pm, pn; };
struct Gemm { const u16* A; const u16* Bt; int M, N, K; int rev; int ablk, bblk; int ubase, ucount; const u16* Bt2; int bsplit; };
struct StaticOrder {
    int nM, nN, nwg, G, c, rev, ubase, ulimit;
    __device__ void init(int M, int N, int G_, int c_, int rev_, int ubase_, int ucount_) { nM = M / BM; nN = N / BM; nwg = nM * nN; G = G_; c = c_; rev = rev_; ubase = ubase_; ulimit = ucount_ > 0 ? ubase_ + ucount_ : 0; }
    __device__ bool next(int i, Unit& u) const {
        if (ulimit) {
            const int L = ubase + i * G + c; if (L >= ulimit) return false;
            if (L < 1024) { const int rd = L >> 8, cc = L & 255, j = cc >> 3; u.pm = rd * 64 + (cc & 7) * 8 + (j & 7); u.pn = j >> 3; }
            else { const int t = L - 1024; u.pm = 256 + (t & 7); u.pn = t >> 3; }
            return true;
        }
        const long L = (long)i * G + c; if (L >= nwg) return false;
        int wgid = (int)L; { const int q = nwg / NXCD, r = nwg % NXCD, xcd = wgid % NXCD, off = wgid / NXCD; wgid = (xcd < r ? xcd * (q + 1) : r * (q + 1) + (xcd - r) * q) + off; }
        const int nig = WGM * nN, gid = wgid / nig, fm = gid * WGM, gsz = (nM - fm) < WGM ? (nM - fm) : WGM;
        u.pm = fm + ((wgid % nig) % gsz); u.pn = (wgid % nig) / gsz; if (rev) u.pm = nM - 1 - u.pm; return true;
    }
};

template <class Epi>
__device__ __forceinline__ void gemm_phase(LAS unsigned char* lds, const Gemm g, const Epi& E) {
    __builtin_amdgcn_sched_barrier(0);
    const int tid = opaque_tid(), wid = __builtin_amdgcn_readfirstlane(tid >> 6), lane = tid & 63, wr = wid >> 2, wc = wid & 3, fr = lane & 15, fq = lane >> 4;
    const int K = g.K, nt = K / BK;
    StaticOrder S; S.init(g.M, g.N, (int)gridDim.x, (int)blockIdx.x, g.rev, g.ubase, g.ucount);
    unsigned voffA[2], voffB[2];
#pragma unroll
    for (int i = 0; i < 2; ++i) { int R, C; stage_rc(tid * 16 + i * 8192, R, C); const int Rb = Epi::PERM ? ((R & ~31) + perm32(R & 31)) : R;
        voffA[i] = (unsigned)(R * (g.ablk ? BK : K) + C) * 2u; voffB[i] = (unsigned)(Rb * (g.bblk ? BK : K) + C) * 2u; }
    const size_t tstep = (size_t)BM * K * 2;
    const size_t kstA = g.ablk ? (size_t)(BM * BK * 2) : (size_t)(BK * 2), kstB = g.bblk ? (size_t)(BM * BK * 2) : (size_t)(BK * 2);
    const size_t hstA = g.ablk ? (size_t)(HALF * BK * 2) : (size_t)HALF * K * 2, hstB = g.bblk ? (size_t)(HALF * BK * 2) : (size_t)HALF * K * 2;
    const unsigned ldsw = (unsigned)wid * 1024u;
    const int aoff = lds_byte(wr * 64 + fr, fq * 8), boff = lds_byte(wc * 32 + fr, fq * 8);
#define PG8_SA(b, h) (((b) * 2 + (h)) * HTB)
#define PG8_SB(b, h) ((4 + (b) * 2 + (h)) * HTB)
#define PG8_STAGE(bufoff, gbase, voff) do { _Pragma("unroll") for (int _i = 0; _i < 2; ++_i) \
        __builtin_amdgcn_global_load_lds((const unsigned*)((const char*)(gbase) + (voff)[_i]), (LAS unsigned*)(lds + (bufoff) + ldsw + _i * 8192), 16, 0, 0); } while (0)
#define PG8_LDA(dst, b, h) do { _Pragma("unroll") for (int m = 0; m < 4; ++m) _Pragma("unroll") for (int k = 0; k < 2; ++k) dst[m][k] = *(const LAS bf16x8*)(lds + PG8_SA(b, h) + aoff + m * 2048 + k * 1024); } while (0)
#define PG8_LDB(dst, b, h) do { _Pragma("unroll") for (int n = 0; n < 2; ++n) _Pragma("unroll") for (int k = 0; k < 2; ++k) dst[n][k] = *(const LAS bf16x8*)(lds + PG8_SB(b, h) + boff + n * 2048 + k * 1024); } while (0)
#define PG8_MMA(ai, bj, At, Bt) do { __builtin_amdgcn_s_setprio(1); _Pragma("unroll") for (int m = 0; m < 4; ++m) _Pragma("unroll") for (int n = 0; n < 2; ++n) _Pragma("unroll") for (int k = 0; k < 2; ++k) \
        acc[ai][bj][m][n] = __builtin_amdgcn_mfma_f32_16x16x32_bf16(Bt[n][k], At[m][k], acc[ai][bj][m][n], 0, 0, 0); __builtin_amdgcn_s_setprio(0); } while (0)
#define PG8_WAIT_V(n) asm volatile("s_waitcnt vmcnt(" #n ")" ::: "memory")
#define PG8_WAIT_L(n) asm volatile("s_waitcnt lgkmcnt(" #n ")" ::: "memory")
#define PG8_BAR __builtin_amdgcn_s_barrier()
#define PG8_SCHED __builtin_amdgcn_sched_barrier(0)
    Unit cur, nxt; int ui = 0;
    if (!S.next(0, cur)) return;
    f32x4 acc[2][2][4][2];
#pragma unroll
    for (int a = 0; a < 2; ++a)
#pragma unroll
        for (int b = 0; b < 2; ++b)
#pragma unroll
            for (int m = 0; m < 4; ++m)
#pragma unroll
                for (int n = 0; n < 2; ++n) acc[a][b][m][n] = (f32x4){0.f, 0.f, 0.f, 0.f};
    bf16x8 At[4][2], B0[2][2], B1[2][2];
    const char* cA = (const char*)g.A + (size_t)cur.pm * tstep; const char* cB = (const char*)((g.Bt2 && cur.pm >= g.bsplit) ? g.Bt2 : g.Bt) + (size_t)cur.pn * tstep;
    PG8_STAGE(PG8_SB(0, 0), cB, voffB); PG8_STAGE(PG8_SA(0, 0), cA, voffA); PG8_STAGE(PG8_SB(0, 1), cB + hstB, voffB); PG8_STAGE(PG8_SA(0, 1), cA + hstA, voffA);
    if (wr == 1) PG8_BAR;
    PG8_WAIT_V(4); PG8_BAR;
    PG8_STAGE(PG8_SB(1, 0), cB + kstB, voffB); PG8_STAGE(PG8_SA(1, 0), cA + kstA, voffA); PG8_STAGE(PG8_SB(1, 1), cB + hstB + kstB, voffB);
    PG8_WAIT_V(6); PG8_BAR;
    for (;;) {
        const bool has_next = S.next(ui + 1, nxt);
        const char* nA = has_next ? (const char*)g.A + (size_t)nxt.pm * tstep : cA; const char* nB = has_next ? (const char*)((g.Bt2 && nxt.pm >= g.bsplit) ? g.Bt2 : g.Bt) + (size_t)nxt.pn * tstep : cB;
        for (int t = 0; t < nt; t += 2) {
            const bool last = (t == nt - 2);
            const char* a1 = cA + (size_t)(t + 1) * kstA;
            const char* a2 = last ? nA : cA + (size_t)(t + 2) * kstA; const char* b2 = last ? nB : cB + (size_t)(t + 2) * kstB;
            const char* a3 = a2 + kstA; const char* b3 = b2 + kstB;
            PG8_LDB(B0, 0, 0); PG8_SCHED; PG8_LDA(At, 0, 0); PG8_STAGE(PG8_SA(1, 1), a1 + hstA, voffA);
            PG8_WAIT_L(8); PG8_BAR; PG8_WAIT_L(0); PG8_MMA(0, 0, At, B0); PG8_BAR; PG8_SCHED;
            PG8_LDB(B1, 0, 1); PG8_STAGE(PG8_SB(0, 0), b2, voffB);
            PG8_BAR; PG8_WAIT_L(0); PG8_MMA(0, 1, At, B1); PG8_BAR;
            PG8_LDA(At, 0, 1); PG8_STAGE(PG8_SA(0, 0), a2, voffA);
            PG8_BAR; PG8_WAIT_L(0); PG8_MMA(1, 0, At, B0); PG8_BAR; PG8_SCHED;
            PG8_STAGE(PG8_SB(0, 1), b2 + hstB, voffB);
            PG8_WAIT_V(6); PG8_BAR; PG8_MMA(1, 1, At, B1); PG8_BAR;
            PG8_LDB(B0, 1, 0); PG8_SCHED; PG8_LDA(At, 1, 0); PG8_STAGE(PG8_SA(0, 1), a2 + hstA, voffA);
            PG8_WAIT_L(8); PG8_BAR; PG8_WAIT_L(0); PG8_MMA(0, 0, At, B0); PG8_BAR; PG8_SCHED;
            PG8_LDB(B1, 1, 1); PG8_STAGE(PG8_SB(1, 0), b3, voffB);
            PG8_BAR; PG8_WAIT_L(0); PG8_MMA(0, 1, At, B1); PG8_BAR;
            PG8_LDA(At, 1, 1); PG8_STAGE(PG8_SA(1, 0), a3, voffA);
            PG8_BAR; PG8_WAIT_L(0); PG8_MMA(1, 0, At, B0); PG8_BAR; PG8_SCHED;
            PG8_STAGE(PG8_SB(1, 1), b3 + hstB, voffB);
            PG8_WAIT_V(6); PG8_BAR; PG8_MMA(1, 1, At, B1); PG8_BAR;
        }
        E(acc, cur, wr, wc, fr, fq);
        if (!has_next) break;
#pragma unroll
        for (int a = 0; a < 2; ++a)
#pragma unroll
            for (int b = 0; b < 2; ++b)
#pragma unroll
                for (int m = 0; m < 4; ++m)
#pragma unroll
                    for (int n = 0; n < 2; ++n) acc[a][b][m][n] = (f32x4){0.f, 0.f, 0.f, 0.f};
        cur = nxt; cA = nA; cB = nB; ++ui;
    }
    PG8_WAIT_V(0);
    if (wr == 0) PG8_BAR;
    PG8_BAR;
    PG8_SCHED;
#undef PG8_SA
#undef PG8_SB
#undef PG8_STAGE
#undef PG8_LDA
#undef PG8_LDB
#undef PG8_MMA
#undef PG8_WAIT_V
#undef PG8_WAIT_L
#undef PG8_BAR
#undef PG8_SCHED
}
}
using pg8::Unit;
typedef f32x4 AccT[2][2][4][2];

struct EpiGU {
    static constexpr bool PERM = true;
    u16* H;
    __device__ __forceinline__ void operator()(const AccT& acc, const Unit& u, int wr, int wc, int fr_, int fq) const {
        int fr = fr_; asm volatile("" : "+v"(fr));
        const int rl = wr * 64 + fr, hc = u.pn * 128 + wc * 32 + 8 * fq;
#pragma unroll
        for (int ai = 0; ai < 2; ++ai)
#pragma unroll
            for (int m = 0; m < 4; ++m) {
                const f32x4 g0 = acc[ai][0][m][0], g1 = acc[ai][0][m][1], u0 = acc[ai][1][m][0], u1 = acc[ai][1][m][1];
                u32x4 o;
                o[0] = pk_bf16(silu_f(g0[0]) * u0[0], silu_f(g0[1]) * u0[1]); o[1] = pk_bf16(silu_f(g0[2]) * u0[2], silu_f(g0[3]) * u0[3]);
                o[2] = pk_bf16(silu_f(g1[0]) * u1[0], silu_f(g1[1]) * u1[1]); o[3] = pk_bf16(silu_f(g1[2]) * u1[2], silu_f(g1[3]) * u1[3]);
                __builtin_nontemporal_store(o, (u32x4*)(H + (size_t)u.pm * (256 * DFF) + (size_t)(hc >> 6) * 16384 + (size_t)(rl + ai * 128 + m * 16) * 64 + (hc & 63)));
            }
    }
};
struct EpiRes {
    static constexpr bool PERM = false;
    _Float16* X; const float* stats; const float* lg; const float* lb; const float* mods_l; int gate_idx; float coef;
    __device__ __forceinline__ void operator()(AccT& acc, const Unit& u, int wr, int wc, int fr_, int fq) const {
        int fr = fr_; asm volatile("" : "+v"(fr));
        const int row0 = u.pm * 256 + wr * 64 + fr, col0 = u.pn * 256 + wc * 32 + 4 * fq;
        const int s = (u.pm >= (TL / 256)) ? 8 : (u.pm >> 5);
        const float* gate = mods_l + (size_t)s * NMOD + gate_idx * DM + col0;
        _Float16* xb = X + (size_t)row0 * DM + col0;
        f32x4 gl[2][2];
#pragma unroll
        for (int bj = 0; bj < 2; ++bj)
#pragma unroll
            for (int n = 0; n < 2; ++n) {
                const f32x4 gv = *(const f32x4*)(gate + bj * 128 + n * 16) * coef, bl = *(const f32x4*)(lb + col0 + bj * 128 + n * 16) * ALPHA;
                gl[bj][n] = *(const f32x4*)(lg + col0 + bj * 128 + n * 16) * ALPHA;
#pragma unroll
                for (int ai = 0; ai < 2; ++ai)
#pragma unroll
                    for (int m = 0; m < 4; ++m) acc[ai][bj][m][n] = gv * acc[ai][bj][m][n] + bl; }
        __builtin_amdgcn_sched_barrier(0);
#pragma unroll
        for (int ai = 0; ai < 2; ++ai) {
            h16x4 xv[4][2][2]; float2 st[4];
#pragma unroll
            for (int m = 0; m < 4; ++m) { st[m] = *(const float2*)(stats + (size_t)(row0 + ai * 128 + m * 16) * 2);
#pragma unroll
                for (int bj = 0; bj < 2; ++bj)
#pragma unroll
                    for (int n = 0; n < 2; ++n) xv[m][bj][n] = *(const h16x4*)(xb + (size_t)(ai * 128 + m * 16) * DM + bj * 128 + n * 16); }
            __builtin_amdgcn_sched_barrier(0);
#pragma unroll
            for (int m = 0; m < 4; ++m)
#pragma unroll
                for (int bj = 0; bj < 2; ++bj)
#pragma unroll
                    for (int n = 0; n < 2; ++n) { const h16x4 xh = xv[m][bj][n]; const f32x4 a = acc[ai][bj][m][n]; h16x4 o;
#pragma unroll
                        for (int e = 0; e < 4; ++e) o[e] = (_Float16)((((float)xh[e] - st[m].x) * st[m].y) * gl[bj][n][e] + a[e]);
                        *(h16x4*)(xb + (size_t)(ai * 128 + m * 16) * DM + bj * 128 + n * 16) = o; }
            __builtin_amdgcn_sched_barrier(0);
        }
    }
};
struct EpiIn {
    static constexpr bool PERM = true;
    u16* P; u16* Vt; u16* Vtc; u16* Ft; u16* Ftc;
    __device__ __forceinline__ void operator()(const AccT& acc, const Unit& u, int wr, int wc, int fr_, int fq) const {
        int fr = fr_; asm volatile("" : "+v"(fr));
        const int row0 = u.pm * 256 + wr * 64 + fr;
        const bool isctx = u.pm >= (TL / 256);
        const int pn = u.pn;
        if (pn == 4 || pn == 5 || pn == 8) {
#pragma unroll
            for (int ai = 0; ai < 2; ++ai)
#pragma unroll
                for (int m = 0; m < 4; ++m) {
                    const int r = row0 + ai * 128 + m * 16;
#pragma unroll
                    for (int bj = 0; bj < 2; ++bj) {
                        const int c = pn * 256 + bj * 128 + wc * 32 + 8 * fq;
                        u16* dst; size_t stride;
                        if (pn == 8) { const int ch = c - 2048;
                            if (isctx) { const int rr = r - TL; dst = Ftc + ((size_t)((rr >> 8) * 256 + ch)) * CTXL + (rr & 255); stride = CTXL; }
                            else { const int n = r & 8191; dst = Ft + (size_t)(r >> 13) * (256 * SEQ) + (size_t)(n >> 6) * 16384 + ch * 64 + (n & 63); stride = 64; }
                        } else { const int hd = c - 1024;
                            if (isctx) { const int rr = r - TL; dst = Vtc + ((size_t)((rr >> 8) * 512 + hd)) * CTXL + (rr & 255); stride = CTXL; }
                            else { dst = Vt + ((size_t)((r >> 13) * 512 + hd)) * VTP + (r & 8191); stride = VTP; }
                        }
#pragma unroll
                        for (int n = 0; n < 2; ++n)
#pragma unroll
                            for (int e = 0; e < 4; ++e) dst[(size_t)(n * 4 + e) * stride] = f2bf(acc[ai][bj][m][n][e]);
                    }
                }
        } else {
            const float sc = pn < 2 ? 0.125f : 1.f;
#pragma unroll
            for (int ai = 0; ai < 2; ++ai)
#pragma unroll
                for (int m = 0; m < 4; ++m) {
                    u16* rowp = P + (size_t)(row0 + ai * 128 + m * 16) * NIN + pn * 256 + wc * 32 + 8 * fq;
#pragma unroll
                    for (int bj = 0; bj < 2; ++bj) { const f32x4 v0 = acc[ai][bj][m][0] * sc, v1 = acc[ai][bj][m][1] * sc;
                        u32x4 o; o[0] = pk_bf16(v0[0], v0[1]); o[1] = pk_bf16(v0[2], v0[3]); o[2] = pk_bf16(v1[0], v1[1]); o[3] = pk_bf16(v1[2], v1[3]);
                        *(u32x4*)(rowp + bj * 128) = o; }
                }
        }
    }
};
struct EpiDft {
    static constexpr bool PERM = true;
    u16* O; int tokbase; int nhl2; int nseq; int folded;
    __device__ __forceinline__ void operator()(const AccT& acc, const Unit& u, int wr, int wc, int fr_, int fq) const {
        int fr = fr_; asm volatile("" : "+v"(fr));
        const int NH = 1 << nhl2;
        const int b = u.pn;
#pragma unroll
        for (int bj = 0; bj < 2; ++bj) {
            const int ch = bj * 128 + wc * 32 + 8 * fq, g = ch >> 6, cgi = ch & 63;
            u16* ob = O + (size_t)(tokbase + b * nseq) * KOUT + 768 + g * 128 + cgi;
#pragma unroll
            for (int ai = 0; ai < 2; ++ai)
#pragma unroll
                for (int m = 0; m < 4; ++m) {
                    const int mrow = u.pm * 256 + ai * 128 + wr * 64 + m * 16 + fr;
                    const int s = folded ? ((mrow >> 11) & 1) : (mrow >> nhl2), k = folded ? (2 * (mrow & 2047) + (mrow >> 12)) : (mrow & (NH - 1));
                    const f32x4 v0 = acc[ai][bj][m][0], v1 = acc[ai][bj][m][1];
                    u32x4 o; o[0] = pk_bf16(v0[0], v0[1]); o[1] = pk_bf16(v0[2], v0[3]); o[2] = pk_bf16(v1[0], v1[1]); o[3] = pk_bf16(v1[2], v1[3]);
                    if (s == 0) { *(u32x4*)(ob + (size_t)k * KOUT) = o; if (k) *(u32x4*)(ob + (size_t)(nseq - k) * KOUT) = o; }
                    else if (k) { *(u32x4*)(ob + (size_t)k * KOUT + 64) = o;
                        o[0] ^= 0x80008000u; o[1] ^= 0x80008000u; o[2] ^= 0x80008000u; o[3] ^= 0x80008000u;
                        *(u32x4*)(ob + (size_t)(nseq - k) * KOUT + 64) = o; }
                    else { *(u32x4*)(ob + (size_t)NH * KOUT) = o; unsigned zz; asm volatile("v_mov_b32 %0, 0" : "=v"(zz)); const u32x4 z = {zz, zz, zz, zz};
                        *(u32x4*)(ob + 64) = z; *(u32x4*)(ob + (size_t)NH * KOUT + 64) = z; }
                    __builtin_amdgcn_sched_barrier(0);
                }
        }
    }
};

struct TrTile { const float* src; u16* dst; int spitch, dpitch; };
constexpr int TRL = 2496;
__device__ __forceinline__ TrTile tr_desc(const float* g1, const float* u1, const float* d1, const float* g2, const float* u2, const float* d2, const float* win, const float* wout, unsigned char* ws, int it) {
    const int l = it / TRL, ti = it % TRL;
    u16* wl = (u16*)(ws + OFF_W) + (size_t)l * W_LAYER;
    TrTile t;
    if (ti < 2112) {
        const int mi = ti / 352, tj = ti % 352, f = mi / 3, kind = mi % 3;
        if (kind < 2) { const int kt = tj / 22, ntl = tj % 22;
            const float* src = (f ? (kind ? u2 : g2) : (kind ? u1 : g1)) + (size_t)l * DM * DFF;
            t.src = src + (size_t)(kt * 64) * DFF + ntl * 128; t.spitch = DFF; t.dpitch = DM;
            t.dst = wl + (f ? W_GU2 : W_GU1) + (size_t)(256 * ntl + kind * 128) * DM + kt * 64;
        } else { const int kt = tj / 8, ntl = tj % 8;
            const float* src = (f ? d2 : d1) + (size_t)l * DFF * DM;
            t.src = src + (size_t)(kt * 64) * DM + ntl * 128; t.spitch = DM; t.dpitch = DFF;
            t.dst = wl + (f ? W_D2 : W_D1) + (size_t)(ntl * 128) * DFF + kt * 64; }
    } else if (ti < 2112 + 288) { const int tj = ti - 2112, kt = tj / 18, ntl = tj % 18;
        t.src = win + (size_t)l * DM * NIN + (size_t)(kt * 64) * NIN + ntl * 128; t.spitch = NIN; t.dpitch = DM;
        t.dst = wl + W_IN + (size_t)(ntl * 128) * DM + kt * 64;
    } else { const int tj = ti - 2400, kt = tj / 8, ntl = tj % 8;
        t.src = wout + (size_t)l * DM * DM + (size_t)(kt * 64) * DM + ntl * 128; t.spitch = DM; t.dpitch = KOUT;
        t.dst = wl + W_OUT + (size_t)(ntl * 128) * KOUT + kt * 64; }
    return t;
}

__device__ __forceinline__ void phase0(unsigned char* shm) {
    const Params p = kparams();
    const int tid = opaque_tid(), bid = blockIdx.x, nb = gridDim.x;
    float* sf = (float*)shm;
    float* mods = (float*)(p.ws + OFF_MOD);
    if (bid < 144) {
        float* sv = sf;
        float* red = sf + 9 * 1024;
        for (int i = tid; i < 9 * 1024; i += NTHREADS) { const int s = i >> 10, k = i & 1023; const float v = (s < 8) ? p.in[1][s * 1024 + k] : p.in[3][k]; sv[i] = silu_f(v); }
        __syncthreads();
        for (int item = bid; item < 144; item += nb) {
            const int l = item / 36, cgp = item % 36, cl = tid & 255, col = cgp * 256 + cl, kh = tid >> 8;
            const float* w = p.in[4] + (size_t)l * DM * NMOD + col;
            float a[9];
#pragma unroll
            for (int s = 0; s < 9; ++s) a[s] = 0.f;
#pragma unroll 16
            for (int k = kh * 512; k < kh * 512 + 512; ++k) { const float wv = w[(size_t)k * NMOD];
#pragma unroll
                for (int s = 0; s < 9; ++s) a[s] += sv[s * 1024 + k] * wv; }
            if (kh == 1) {
#pragma unroll
                for (int s = 0; s < 9; ++s) red[cl * 9 + s] = a[s]; }
            __syncthreads();
            if (kh == 0) { const float bb = p.in[5][l * NMOD + col];
#pragma unroll
                for (int s = 0; s < 9; ++s) mods[(size_t)(l * 9 + s) * NMOD + col] = a[s] + red[cl * 9 + s] + bb; }
            __syncthreads();
        }
    }
    __syncthreads();
    {
        float* tile = sf;
        const int ntile = DEPTH * TRL;
        f32x4 nv[4];
        const int kk0 = tid >> 5, n4 = tid & 31;
        int it = bid;
        if (it < ntile) { const TrTile t = tr_desc(p.in[8], p.in[9], p.in[10], p.in[11], p.in[12], p.in[13], p.in[14], p.in[15], p.ws, it);
#pragma unroll
            for (int i = 0; i < 4; ++i) nv[i] = *(const f32x4*)(t.src + (size_t)(kk0 + 16 * i) * t.spitch + n4 * 4); }
        for (; it < ntile; it += nb) {
            const TrTile t = tr_desc(p.in[8], p.in[9], p.in[10], p.in[11], p.in[12], p.in[13], p.in[14], p.in[15], p.ws, it);
#pragma unroll
            for (int i = 0; i < 4; ++i) { float* tp = tile + (kk0 + 16 * i) * 129 + n4 * 4; tp[0] = nv[i][0]; tp[1] = nv[i][1]; tp[2] = nv[i][2]; tp[3] = nv[i][3]; }
            __syncthreads();
            if (it + nb < ntile) { const TrTile tn = tr_desc(p.in[8], p.in[9], p.in[10], p.in[11], p.in[12], p.in[13], p.in[14], p.in[15], p.ws, it + nb);
#pragma unroll
                for (int i = 0; i < 4; ++i) nv[i] = *(const f32x4*)(tn.src + (size_t)(kk0 + 16 * i) * tn.spitch + n4 * 4); }
            { const int nn = tid >> 2, ks = (tid & 3) * 16;
#pragma unroll
              for (int hv = 0; hv < 2; ++hv) { u32x4 o;
#pragma unroll
                  for (int e = 0; e < 4; ++e) o[e] = pk_bf16(tile[(ks + hv * 8 + 2 * e) * 129 + nn], tile[(ks + hv * 8 + 2 * e + 1) * 129 + nn]);
                  *(u32x4*)(t.dst + (size_t)nn * t.dpitch + ks + hv * 8) = o; } }
            __syncthreads();
        }
    }
    {
        float* Mx = sf;
        float* ctab = sf + 8192;
        if (tid < 64) ctab[tid] = cospif((float)tid * (1.f / 32.f));
        __syncthreads();
        for (int it = nb - 1 - bid; it < DEPTH * 16; it += nb) {
            const int l = it >> 4, g = (it >> 2) & 3, jq = it & 3;
            const float* fw = p.in[24] + (size_t)(l * 4 + g) * 4096;
            for (int o = tid; o < 8192; o += NTHREADS) { const int kk = o >> 6, d = o & 63, c = kk & 63; float a = 0.f;
                for (int c2 = 0; c2 < 64; ++c2) { const int ph = (c * c2) & 63; const float tv = ctab[(kk < 64) ? ph : ((ph + 48) & 63)]; a += tv * fw[c2 * 64 + d]; }
                Mx[o] = a; }
            __syncthreads();
            { const int j = jq * 256 + (tid & 255), kkh = tid >> 8;
              const float* wo = p.in[15] + (size_t)l * DM * DM + (size_t)(768 + 64 * g) * DM + j;
              float a[64];
#pragma unroll
              for (int q = 0; q < 64; ++q) a[q] = 0.f;
              for (int d = 0; d < 64; ++d) { const float wv = wo[(size_t)d * DM];
#pragma unroll
                  for (int q = 0; q < 64; ++q) a[q] += Mx[(kkh * 64 + q) * 64 + d] * wv; }
              u16* dst = (u16*)(p.ws + OFF_W) + (size_t)l * W_LAYER + W_OUT + (size_t)j * KOUT + 768 + g * 128 + kkh * 64;
#pragma unroll
              for (int q8 = 0; q8 < 8; ++q8) { u32x4 o;
#pragma unroll
                  for (int e = 0; e < 4; ++e) o[e] = pk_bf16(a[q8 * 8 + 2 * e], a[q8 * 8 + 2 * e + 1]);
                  *(u32x4*)(dst + q8 * 8) = o; } }
            __syncthreads();
        }
    }
    if (bid == 0) { float* idv = (float*)(p.ws + OFF_ID); for (int i = tid; i < 2 * DM; i += NTHREADS) idv[i] = i < DM ? 1.f : 0.f; }
    { u16* lw = (u16*)(p.ws + OFF_LW);
      for (int i = bid * NTHREADS + tid; i < DEPTH * 16 * 4096; i += nb * NTHREADS) {
          const int c = i & 63, d = (i >> 6) & 63, hd = (i >> 12) & 3, gt = (i >> 14) & 1, ld = i >> 15;
          const float* src = gt ? p.in[21] : p.in[19];
          lw[i] = f2bf(src[((size_t)(ld * 4 + hd) * 64 + c) * 64 + d]); } }
    {
        u16* tab = (u16*)shm;
        const float scl = 0.001381067932004976f;
        for (int i = tid; i < 8192; i += NTHREADS) tab[i] = f2bf(scl * cospif((float)i * (1.f / 4096.f)));
        __syncthreads();
        u16* A = (u16*)(p.ws + OFF_DFT);
        for (int it = bid; it < 1024; it += nb) {
            for (int rr = 0; rr < 8; ++rr) { const int m = it * 8 + rr, blk = m >> 11, idx = m & 2047;
                const bool special = (blk == 1 && idx == 0);
                const int kk = special ? 4096 : 2 * idx + (blk >> 1), off = ((blk & 1) && !special) ? 2048 : 0;
                { const int n0 = tid * 8; u32x4 o;
#pragma unroll
                    for (int e = 0; e < 4; ++e) { const unsigned lo = tab[(kk * (n0 + 2 * e) + off) & 8191], hi = tab[(kk * (n0 + 2 * e + 1) + off) & 8191]; o[e] = lo | (hi << 16); }
                    *(u32x4*)(A + (size_t)(m >> 8) * (256 * 4096) + (size_t)(n0 >> 6) * 16384 + (m & 255) * 64 + (n0 & 63)) = o; } }
        }
        if (bid == nb - 1) { u16* Ac = (u16*)(p.ws + OFF_DFTC); const float sc = 0.0078125f;
            for (int i = tid; i < 65536; i += NTHREADS) { const int m = i >> 8, n = i & 255, kk = (m == 128) ? 128 : (m & 127); const float ang = (float)((kk * n) & 255) * (1.f / 128.f);
                Ac[i] = f2bf(m > 128 ? -sc * sinpif(ang) : sc * cospif(ang)); } }
        __syncthreads();
    }
}

__device__ __forceinline__ float wave_sum(float v) {
#pragma unroll
    for (int o = 32; o >= 1; o >>= 1) v += __shfl_xor(v, o, 64);
    return v;
}
constexpr int LNR = 4;
__device__ __forceinline__ f32x8 ld8f(const float* p) { const f32x4 a = *(const f32x4*)p, b = *(const f32x4*)(p + 4); return (f32x8){a[0], a[1], a[2], a[3], b[0], b[1], b[2], b[3]}; }
template <int MODE>
__device__ __forceinline__ void ln_phase(const float* src_lat, const float* src_ctx, _Float16* X, float* stats, float* outf, u16* h, const float* g, const float* bt, const float* mods_l, int sub, int nrows, int row_lo = 0, int blk_lo = 0) {
    const int tid = opaque_tid(), lane = tid & 63, gwv = ((int)blockIdx.x - blk_lo) * 8 + (tid >> 6);
    int nw = ((int)gridDim.x - blk_lo) * 8; asm volatile("" : "+s"(nw));
    if ((int)blockIdx.x < blk_lo) return;
    const int c0 = lane * 8;
    h16x8 nx[LNR][2];
    if (MODE != 0) { const int rf = row_lo + gwv * LNR;
        if (rf < nrows) {
#pragma unroll
            for (int j = 0; j < LNR; ++j)
#pragma unroll
                for (int i = 0; i < 2; ++i) nx[j][i] = *(const h16x8*)(X + (size_t)(rf + j) * DM + i * 512 + c0); }
    }
    for (int r0 = row_lo + gwv * LNR; r0 < nrows; r0 += LNR * nw) {
        f32x8 v[LNR][2]; int rr[LNR]; bool ok[LNR];
#pragma unroll
        for (int j = 0; j < LNR; ++j) { ok[j] = true; rr[j] = r0 + j; }
#pragma unroll
        for (int j = 0; j < LNR; ++j) {
            const int r = rr[j];
            if (MODE == 0) { const float* src = (r >= TL) ? src_ctx + (size_t)(r - TL) * DM : src_lat + (size_t)r * DM;
#pragma unroll
                for (int i = 0; i < 2; ++i) v[j][i] = ld8f(src + i * 512 + c0);
            } else {
#pragma unroll
                for (int i = 0; i < 2; ++i) { const h16x8 t = nx[j][i];
#pragma unroll
                    for (int e = 0; e < 8; ++e) v[j][i][e] = (float)t[e]; }
            }
        }
        if (MODE != 0) {
            const int rn0 = r0 + LNR * nw;
            if (rn0 < nrows) {
#pragma unroll
                for (int j = 0; j < LNR; ++j)
#pragma unroll
                    for (int i = 0; i < 2; ++i) nx[j][i] = *(const h16x8*)(X + (size_t)(rn0 + j) * DM + i * 512 + c0); }
        }
        float mean[LNR], rstd[LNR];
#pragma unroll
        for (int j = 0; j < LNR; ++j) { mean[j] = 0.f; rstd[j] = 1.f; }
        if (MODE != 0) {
#pragma unroll
            for (int j = 0; j < LNR; ++j) { float sm = 0.f;
#pragma unroll
                for (int i = 0; i < 2; ++i)
#pragma unroll
                    for (int e = 0; e < 8; ++e) sm += v[j][i][e];
                mean[j] = sm; }
#pragma unroll
            for (int o = 32; o >= 1; o >>= 1)
#pragma unroll
                for (int j = 0; j < LNR; ++j) mean[j] += __shfl_xor(mean[j], o, 64);
#pragma unroll
            for (int j = 0; j < LNR; ++j) { mean[j] *= (1.f / 1024.f); float sq = 0.f;
#pragma unroll
                for (int i = 0; i < 2; ++i)
#pragma unroll
                    for (int e = 0; e < 8; ++e) { const float d = v[j][i][e] - mean[j]; v[j][i][e] = d; sq += d * d; }
                rstd[j] = sq; }
#pragma unroll
            for (int o = 32; o >= 1; o >>= 1)
#pragma unroll
                for (int j = 0; j < LNR; ++j) rstd[j] += __shfl_xor(rstd[j], o, 64);
#pragma unroll
            for (int j = 0; j < LNR; ++j) rstd[j] = 1.f / sqrtf(rstd[j] * (1.f / 1024.f) + LN_EPS);
        }
        const bool grouped = true;
        const int sset = (r0 >= TL) ? 8 : (r0 >> 13);
#pragma unroll
        for (int i = 0; i < 2; ++i) {
            f32x8 gg, bb, ma, mc;
            if (MODE != 0) { gg = ld8f(g + i * 512 + c0); bb = ld8f(bt + i * 512 + c0); }
            if (MODE != 2) { const float* sh = mods_l + (size_t)sset * NMOD + (3 * sub) * DM + i * 512 + c0; ma = ld8f(sh); mc = ld8f(sh + DM) + 1.f; }
#pragma unroll
            for (int j = 0; j < LNR; ++j) {
                if (!ok[j]) continue;
                const int r = rr[j];
                f32x8 x = v[j][i];
                if (MODE != 0) x = x * rstd[j] * gg + bb;
                if (MODE == 2) { float* o = outf + (size_t)r * DM + i * 512 + c0;
                    __builtin_nontemporal_store((f32x4){x[0], x[1], x[2], x[3]}, (f32x4*)o); __builtin_nontemporal_store((f32x4){x[4], x[5], x[6], x[7]}, (f32x4*)(o + 4));
                } else {
                    if (MODE == 0) { h16x8 t;
#pragma unroll
                        for (int e = 0; e < 8; ++e) t[e] = (_Float16)x[e];
                        *(h16x8*)(X + (size_t)r * DM + i * 512 + c0) = t; }
                    if (i == 0 && lane == 0) *(float2*)(stats + (size_t)r * 2) = make_float2(mean[j], rstd[j]);
                    if (!grouped) { const int s2 = (r >= TL) ? 8 : (r >> 13); const float* sh = mods_l + (size_t)s2 * NMOD + (3 * sub) * DM + i * 512 + c0; ma = ld8f(sh); mc = ld8f(sh + DM) + 1.f; }
                    const f32x8 hv = x * mc + ma; u32x4 o; o[0] = pk_bf16(hv[0], hv[1]); o[1] = pk_bf16(hv[2], hv[3]); o[2] = pk_bf16(hv[4], hv[5]); o[3] = pk_bf16(hv[6], hv[7]);
                    *(u32x4*)(h + (size_t)r * DM + i * 512 + c0) = o;
                }
            }
        }
    }
}

template <bool APPLY>
__device__ __forceinline__ void lru_pass(int l, unsigned char* shm) {
    const Params p = kparams();
    const int tid = opaque_tid(), dir = tid >> 8, ch = tid & 255;
    const int w = tid >> 6, lane = tid & 63, fr = lane & 15, fq = lane >> 4, hd = w & 3;
    const u16* P = (const u16*)(p.ws + OFF_P);
    u16* O = (u16*)(p.ws + OFF_O);
    float2* sums = (float2*)(p.ws + OFF_LRU);
    constexpr int AP = 260, XP = 264;
    u16* xraw = (u16*)shm;
    float* Aa = (float*)shm;
    float* Bb = (float*)(shm + 2 * 32 * AP * 4);
    u16* xcb = (u16*)(shm + 4 * 32 * AP * 4);
    bf16x8 wfr[2][4][2];
#pragma unroll
    for (int gt = 0; gt < 2; ++gt) { const u16* lw = (const u16*)(p.ws + OFF_LW) + ((size_t)(((l * 2 + dir) * 2 + gt) * 4 + hd)) * 4096;
#pragma unroll
        for (int nt = 0; nt < 4; ++nt)
#pragma unroll
            for (int ks = 0; ks < 2; ++ks) wfr[gt][nt][ks] = *(const bf16x8*)(lw + (nt * 16 + fr) * 64 + ks * 32 + fq * 8); }
    float ba4[4], bx4[4], sp4[4];
#pragma unroll
    for (int nt = 0; nt < 4; ++nt) { const int c = (l * 2 + dir) * 256 + hd * 64 + nt * 16 + fr; ba4[nt] = p.in[20][c] * -1.4426950408889634f; bx4[nt] = p.in[22][c] * -1.4426950408889634f;
        sp4[nt] = -8.f * 1.4426950408889634f * log1pf(expf(-p.in[23][c])); }
    float cw[4];
#pragma unroll
    for (int t = 0; t < 4; ++t) cw[t] = p.in[17][(l * 4 + t) * 256 + ch];
    const float cb = p.in[18][l * 256 + ch];
#define LRU_LOAD_XRAW(ITEM, DST) do { const int _b = (ITEM) / 264, _q = (ITEM) % 264; const bool _c = _q < 8; \
        const int _pos0 = _c ? _q * 32 : (_q - 8) * 32, _nseq = _c ? CTXL : SEQ, _tok0 = _c ? TL + _b * CTXL : _b * SEQ; \
        _Pragma("unroll") for (int _k = 0; _k < 3; ++_k) { const int _i = tid + NTHREADS * _k; u32x4 _v = {0u, 0u, 0u, 0u}; \
            if (_i < 35 * 32) { const int _rr = _i >> 5, _c8 = (_i & 31) * 8, _pos = _pos0 - 2 + _rr; \
                if (_pos >= 0 && _pos < _nseq) _v = *(const u32x4*)(P + (size_t)(_tok0 + _pos) * NIN + 1536 + _c8); } \
            DST[_k] = _v; } } while (0)
    u32x4 xnext[3];
    if (!APPLY && (int)blockIdx.x < NB * 264) LRU_LOAD_XRAW((int)blockIdx.x, xnext);
    for (int item = blockIdx.x; item < NB * 264; item += gridDim.x) {
        const int b = item / 264, q = item % 264;
        const bool isctx = q < 8;
        const int pos0 = isctx ? q * 32 : (q - 8) * 32, tok0 = isctx ? TL + b * CTXL : b * SEQ;
        if (APPLY) LRU_LOAD_XRAW(item, xnext);
#pragma unroll
        for (int k = 0; k < 3; ++k) { const int i = tid + NTHREADS * k; if (i < 35 * 32) *(u32x4*)(xraw + (i >> 5) * 256 + (i & 31) * 8) = xnext[k]; }
        __syncthreads();
        if (!APPLY && item + (int)gridDim.x < NB * 264) LRU_LOAD_XRAW(item + (int)gridDim.x, xnext);
#pragma unroll 4
        for (int i = 0; i < 16; ++i) { const int pp = dir + 2 * i; float a = cb;
#pragma unroll
            for (int t = 0; t < 4; ++t) a += cw[t] * bf2f(xraw[(pp + t) * 256 + ch]);
            xcb[pp * XP + ch] = f2bf(a); }
        __syncthreads();
        {
            bf16x8 xa[2][2];
#pragma unroll
            for (int pt = 0; pt < 2; ++pt)
#pragma unroll
                for (int ks = 0; ks < 2; ++ks) xa[pt][ks] = *(const bf16x8*)(xcb + (pt * 16 + fr) * XP + hd * 64 + ks * 32 + fq * 8);
#pragma unroll
            for (int pt = 0; pt < 2; ++pt)
#pragma unroll
                for (int nt = 0; nt < 4; ++nt) {
                    f32x4 pa = {0.f, 0.f, 0.f, 0.f}, pi = {0.f, 0.f, 0.f, 0.f};
#pragma unroll
                    for (int ks = 0; ks < 2; ++ks) { pa = __builtin_amdgcn_mfma_f32_16x16x32_bf16(xa[pt][ks], wfr[0][nt][ks], pa, 0, 0, 0); pi = __builtin_amdgcn_mfma_f32_16x16x32_bf16(xa[pt][ks], wfr[1][nt][ks], pi, 0, 0, 0); }
                    const int chn = hd * 64 + nt * 16 + fr;
#pragma unroll
                    for (int j2 = 0; j2 < 2; ++j2) {
                        typedef float f32x2 __attribute__((ext_vector_type(2)));
                        const int pos = pt * 16 + fq * 4 + 2 * j2;
                        const f32x2 za = (f32x2){pa[2 * j2], pa[2 * j2 + 1]} * -1.4426950408889634f + ba4[nt];
                        const f32x2 zi = (f32x2){pi[2 * j2], pi[2 * j2 + 1]} * -1.4426950408889634f + bx4[nt];
                        const f32x2 da = (f32x2){__builtin_amdgcn_exp2f(za[0]), __builtin_amdgcn_exp2f(za[1])} + 1.f;
                        const f32x2 di = (f32x2){__builtin_amdgcn_exp2f(zi[0]), __builtin_amdgcn_exp2f(zi[1])} + 1.f;
                        const f32x2 rg = (f32x2){__builtin_amdgcn_rcpf(da[0]), __builtin_amdgcn_rcpf(da[1])};
                        const f32x2 ig = (f32x2){__builtin_amdgcn_rcpf(di[0]), __builtin_amdgcn_rcpf(di[1])};
                        const f32x2 e2 = rg * sp4[nt];
                        const f32x2 a = (f32x2){__builtin_amdgcn_exp2f(e2[0]), __builtin_amdgcn_exp2f(e2[1])};
                        const f32x2 t2 = e2 * 1.3862943611198906f;
                        f32x2 q = t2 * 0.0083333333f + 0.041666667f; q = q * t2 + 0.16666667f; q = q * t2 + 0.5f; q = q * t2 + 1.f;
                        const f32x2 omp = -t2 * q;
                        const f32x2 omd = 1.f - a * a;
                        const f32x2 om = (f32x2){t2[0] > -0.25f ? omp[0] : omd[0], t2[1] > -0.25f ? omp[1] : omd[1]};
                        const f32x2 xv = (f32x2){bf2f(xcb[pos * XP + chn]), bf2f(xcb[(pos + 1) * XP + chn])};
                        const f32x2 bt = (f32x2){__builtin_amdgcn_sqrtf(om[0]), __builtin_amdgcn_sqrtf(om[1])} * (ig * xv);
                        Aa[(dir * 32 + pos) * AP + chn] = a[0]; Aa[(dir * 32 + pos + 1) * AP + chn] = a[1];
                        Bb[(dir * 32 + pos) * AP + chn] = bt[0]; Bb[(dir * 32 + pos + 1) * AP + chn] = bt[1]; }
                    __builtin_amdgcn_sched_barrier(0);
                }
        }
        float hcar = 0.f; u16 grv[16];
        if (APPLY) {
            hcar = ((const float*)(p.ws + OFF_CAR))[((size_t)(b * 264 + q) * 2 + dir) * 256 + ch];
#pragma unroll
            for (int i = 0; i < 16; ++i) grv[i] = P[(size_t)(tok0 + pos0 + dir + 2 * i) * NIN + 1792 + ch];
        }
        __syncthreads();
        float h = 0.f, A = 1.f;
        if (APPLY) h = hcar;
#pragma unroll 8
        for (int st = 0; st < 32; ++st) { const int pp = dir ? 31 - st : st; const float a = Aa[(dir * 32 + pp) * AP + ch], bt = Bb[(dir * 32 + pp) * AP + ch];
            h = a * h + bt; A *= a; if (APPLY) Bb[(dir * 32 + pp) * AP + ch] = h;
            if (!APPLY) {
                unsigned char* prow = (unsigned char*)(p.ws + OFF_P) + (size_t)(tok0 + pos0 + pp) * (NIN * 2);
                *(_Float16*)(prow + 2048 + (dir * 256 + ch) * 2) = (_Float16)h;
                prow[4096 + dir * 256 + ch] = (unsigned char)(A * 255.f + 0.5f); } }
        if (!APPLY) { sums[((size_t)(b * 264 + q) * 2 + dir) * 256 + ch] = make_float2(A, h); }
        else {
            __syncthreads();
#pragma unroll
            for (int i = 0; i < 16; ++i) { const int pp = dir + 2 * i; const size_t tok = (size_t)(tok0 + pos0 + pp);
                const float gr = bf2f(grv[i]);
                O[tok * KOUT + 512 + ch] = f2bf((Bb[pp * AP + ch] + Bb[(32 + pp) * AP + ch]) * gelu_tanh(gr)); }
        }
        __syncthreads();
    }
}

#undef LRU_LOAD_XRAW
typedef unsigned char u8x8 __attribute__((ext_vector_type(8)));
__device__ __forceinline__ void lru_apply() {
    const Params p = kparams();
    const int tid = opaque_tid();
    const unsigned char* Pb = (const unsigned char*)(p.ws + OFF_P);
    u16* O = (u16*)(p.ws + OFF_O);
    const float* car = (const float*)(p.ws + OFF_CAR);
    for (int item = blockIdx.x; item < NB * 264; item += gridDim.x) {
        const int b = item / 264, q = item % 264;
        const bool isctx = q < 8;
        const int pos0 = isctx ? q * 32 : (q - 8) * 32, tok0 = isctx ? TL + b * CTXL : b * SEQ;
        const int ch0 = (tid & 31) * 8;
        const float* cf = car + ((size_t)(b * 264 + q) * 2) * 256 + ch0;
        const f32x8 carF = ld8f(cf), carR = ld8f(cf + 256);
#pragma unroll
        for (int u = 0; u < 2; ++u) {
            const int pos = (tid >> 5) + 16 * u;
            const unsigned char* prow = Pb + (size_t)(tok0 + pos0 + pos) * (NIN * 2);
            const h16x8 hf = *(const h16x8*)(prow + 2048 + ch0 * 2), hr = *(const h16x8*)(prow + 2048 + (256 + ch0) * 2);
            const u8x8 af = *(const u8x8*)(prow + 4096 + ch0), ar = *(const u8x8*)(prow + 4096 + 256 + ch0);
            const bf16x8 gr = *(const bf16x8*)(prow + (1792 + ch0) * 2);
            float o[8];
#pragma unroll
            for (int e = 0; e < 8; ++e) { const float hsum = (float)hf[e] + (float)hr[e] + ((float)af[e] * carF[e] + (float)ar[e] * carR[e]) * (1.f / 255.f);
                o[e] = hsum * gelu_tanh(bf2f((u16)gr[e])); }
            u32x4 ov; ov[0] = pk_bf16(o[0], o[1]); ov[1] = pk_bf16(o[2], o[3]); ov[2] = pk_bf16(o[4], o[5]); ov[3] = pk_bf16(o[6], o[7]);
            *(u32x4*)(O + (size_t)(tok0 + pos0 + pos) * KOUT + 512 + ch0) = ov;
        }
    }
}

__device__ __forceinline__ void lru_prefix() {
    const Params p = kparams();
    const int tid = opaque_tid();
    const int chain = blockIdx.x * NTHREADS + tid;
    if (chain >= NB * 512) return;
    const int b = chain >> 9, dir = (chain >> 8) & 1, ch = chain & 255;
    const float2* sb = (const float2*)(p.ws + OFF_LRU) + ((size_t)b * 264 * 2 + dir) * 256 + ch;
    float* cb = (float*)(p.ws + OFF_CAR) + ((size_t)b * 264 * 2 + dir) * 256 + ch;
    float h = 0.f;
    for (int i0 = 0; i0 < 264; i0 += 8) {
        float2 ab[8]; int qq[8];
#pragma unroll
        for (int j = 0; j < 8; ++j) { const int i = i0 + j; qq[j] = dir ? (i < 8 ? 7 - i : 271 - i) : i; ab[j] = sb[(size_t)qq[j] * 512]; }
#pragma unroll
        for (int j = 0; j < 8; ++j) { cb[(size_t)qq[j] * 512] = h; h = ab[j].x * h + ab[j].y; }
    }
}

__device__ __forceinline__ void ft_fold() {
    const Params p = kparams();
    const int tid = opaque_tid();
    const u16* Ft = (const u16*)(p.ws + OFF_FT);
    u16* GE = (u16*)(p.ws + OFF_GE); u16* GO = (u16*)(p.ws + OFF_GO);
    const int nvec = NB * 64 * 256 * 8;
    for (int v = blockIdx.x * NTHREADS + tid; v < nvec; v += gridDim.x * NTHREADS) {
        const int b = v >> 17, rem = v & 131071;
        const size_t src = ((size_t)b * 128 * 256 * 64) + (size_t)rem * 8;
        const bf16x8 lo = *(const bf16x8*)(Ft + src), hi = *(const bf16x8*)(Ft + src + (size_t)64 * 256 * 64);
        u32x4 e, o;
#pragma unroll
        for (int j = 0; j < 4; ++j) { const float a0 = bf2f((u16)lo[2 * j]), a1 = bf2f((u16)lo[2 * j + 1]), b0 = bf2f((u16)hi[2 * j]), b1 = bf2f((u16)hi[2 * j + 1]);
            e[j] = pk_bf16(a0 + b0, a1 + b1); o[j] = pk_bf16(a0 - b0, a1 - b1); }
        *(u32x4*)(GE + (size_t)v * 8) = e; *(u32x4*)(GO + (size_t)v * 8) = o;
    }
}

__device__ __forceinline__ void attn_phase(int l, unsigned char* shm) {
    const Params p = kparams();
    const int tid = opaque_tid(), w = tid >> 6, lane = tid & 63, fr = lane & 15, fq = lane >> 4;
    const u16* P = (const u16*)(p.ws + OFF_P);
    const u16* Vt = (const u16*)(p.ws + OFF_VT);
    u16* O = (u16*)(p.ws + OFF_O);
    constexpr int KP = 72, VP = 264;
    u16* Kc = (u16*)shm;
    u16* Vc = (u16*)(shm + 256 * KP * 2);
    float* rp = (float*)(shm + 256 * KP * 2 + 64 * VP * 2);
    const float NEG = -__builtin_huge_valf();
    const int krow = 8 * (fr >> 2) + (fr & 3);
    for (int combo = blockIdx.x; combo < NB * 8 * 4; combo += gridDim.x) {
        const int xj = combo >> 3, ph = (xj >> 2) * 8 + (combo & 7), b = ph >> 3, hh = ph & 7, qr = xj & 3;
        __syncthreads();
        { const int row = tid >> 1, half = tid & 1; const u16* src = P + (size_t)(TL + b * CTXL + row) * NIN + 512 + hh * 64 + half * 32; u16* dst = Kc + row * KP + half * 32;
#pragma unroll
          for (int i = 0; i < 4; ++i) *(u32x4*)(dst + i * 8) = *(const u32x4*)(src + i * 8); }
        { const int d = tid >> 3, seg = tid & 7; const u16* src = (const u16*)(p.ws + OFF_VTC) + ((size_t)((b * 8 + hh) * 64 + d)) * CTXL + seg * 32; u16* dst = Vc + d * VP + seg * 32;
#pragma unroll
          for (int i = 0; i < 4; ++i) *(u32x4*)(dst + i * 8) = *(const u32x4*)(src + i * 8); }
        for (int i = tid; i < 465; i += NTHREADS) rp[i] = p.in[16][(size_t)l * 3720 + hh * 465 + i];
        __syncthreads();
        const int nsteps = (l == DEPTH - 1) ? 16 : 17;
        for (int it = 0; it < nsteps; ++it) {
            bool local; int r = 0, jb = 0, qtok0;
            if (it < 16) { const int i = it * 8 + w; local = true; r = qr * 32 + (i >> 2); jb = i & 3; qtok0 = b * SEQ + r * 64 + jb * 16; }
            else { if (w >= 4) continue; local = false; qtok0 = TL + b * CTXL + (qr * 4 + w) * 16; }
            const int rs = min(max(r - 4, 0), 120);
            const int cstart = jb == 0 ? 0 : (jb == 1 ? 8 : (jb == 2 ? 24 : 32));
            bf16x8 qf[2];
#pragma unroll
            for (int ks = 0; ks < 2; ++ks) qf[ks] = *(const bf16x8*)(P + (size_t)(qtok0 + fr) * NIN + hh * 64 + ks * 32 + fq * 8);
            f32x4 sl[16], sc[16];
            float mx = NEG;
            bf16x8 vl[2][4];
            if (local) {
                const int qc = jb * 16 + fr, col0 = min(max(qc - 8, 0), 48);
                const int kcb = cstart + 8 * fq - col0;
                const float* rpl = rp + (cstart + 8 * fq - qc + 15) + (rs - r + 7) * 31;
                const u16* kbase = P + ((size_t)b * SEQ + rs * 64 + cstart + krow) * NIN + 512 + hh * 64 + fq * 8;
#pragma unroll
                for (int hf = 0; hf < 2; ++hf) {
                    bf16x8 kf[4][2][2];
#pragma unroll
                    for (int i4 = 0; i4 < 4; ++i4)
#pragma unroll
                        for (int o = 0; o < 2; ++o) { const u16* kp = kbase + (size_t)((hf * 4 + i4) * 64 + 4 * o) * NIN; kf[i4][o][0] = *(const bf16x8*)kp; kf[i4][o][1] = *(const bf16x8*)(kp + 32); }
                    __builtin_amdgcn_sched_barrier(0);
#pragma unroll
                    for (int i4 = 0; i4 < 4; ++i4)
#pragma unroll
                        for (int o = 0; o < 2; ++o) { const int i = hf * 4 + i4;
                            f32x4 a = {0.f, 0.f, 0.f, 0.f};
                            a = __builtin_amdgcn_mfma_f32_16x16x32_bf16(kf[i4][o][0], qf[0], a, 0, 0, 0);
                            a = __builtin_amdgcn_mfma_f32_16x16x32_bf16(kf[i4][o][1], qf[1], a, 0, 0, 0);
#pragma unroll
                            for (int j = 0; j < 4; ++j) { const bool valid = (unsigned)(kcb + 4 * o + j) < 16u;
                                const float sv = valid ? a[j] + rpl[i * 31 + 4 * o + j] : NEG; a[j] = sv; mx = fmaxf(mx, sv); }
                            sl[i * 2 + o] = a; }
                    __builtin_amdgcn_sched_barrier(0);
                }
#pragma unroll
                for (int t = 0; t < 2; ++t)
#pragma unroll
                    for (int db = 0; db < 4; ++db) vl[t][db] = *(const bf16x8*)(Vt + ((size_t)((b * 8 + hh) * 64 + db * 16 + fr)) * VTP + (rs + t) * 64 + cstart + 8 * fq);
                __builtin_amdgcn_sched_barrier(0);
            } else {
#pragma unroll
                for (int i = 0; i < 16; ++i) sl[i] = (f32x4){NEG, NEG, NEG, NEG};
            }
#pragma unroll
            for (int t = 0; t < 8; ++t)
#pragma unroll
                for (int o = 0; o < 2; ++o) {
                    const u16* kp = Kc + (32 * t + krow + 4 * o) * KP + fq * 8;
                    const bf16x8 k0 = *(const bf16x8*)kp, k1 = *(const bf16x8*)(kp + 32);
                    f32x4 a = {0.f, 0.f, 0.f, 0.f};
                    a = __builtin_amdgcn_mfma_f32_16x16x32_bf16(k0, qf[0], a, 0, 0, 0);
                    a = __builtin_amdgcn_mfma_f32_16x16x32_bf16(k1, qf[1], a, 0, 0, 0);
                    sc[2 * t + o] = a; mx = fmaxf(mx, fmaxf(fmaxf(a[0], a[1]), fmaxf(a[2], a[3])));
                }
            mx = fmaxf(mx, __shfl_xor(mx, 16, 64)); mx = fmaxf(mx, __shfl_xor(mx, 32, 64));
            float sum = 0.f; const float nmx = -mx * 1.4426950408889634f;
#pragma unroll
            for (int i = 0; i < 16; ++i) {
#pragma unroll
                for (int j = 0; j < 4; ++j) { const float e0 = __builtin_amdgcn_exp2f(fmaf(sl[i][j], 1.4426950408889634f, nmx)), e1 = __builtin_amdgcn_exp2f(fmaf(sc[i][j], 1.4426950408889634f, nmx)); sl[i][j] = e0; sc[i][j] = e1; sum += e0 + e1; } }
            sum += __shfl_xor(sum, 16, 64); sum += __shfl_xor(sum, 32, 64);
            f32x4 oa[4];
#pragma unroll
            for (int db = 0; db < 4; ++db) oa[db] = (f32x4){0.f, 0.f, 0.f, 0.f};
#pragma unroll
            for (int bt = 0; bt < 4; ++bt) {
                if (local) {
#pragma unroll
                    for (int t2 = 0; t2 < 2; ++t2) { const int t = bt * 2 + t2;
                        u32x4 pf; pf[0] = pk_bf16(sl[2 * t][0], sl[2 * t][1]); pf[1] = pk_bf16(sl[2 * t][2], sl[2 * t][3]); pf[2] = pk_bf16(sl[2 * t + 1][0], sl[2 * t + 1][1]); pf[3] = pk_bf16(sl[2 * t + 1][2], sl[2 * t + 1][3]);
                        const bf16x8 pa = __builtin_bit_cast(bf16x8, pf);
#pragma unroll
                        for (int db = 0; db < 4; ++db) oa[db] = __builtin_amdgcn_mfma_f32_16x16x32_bf16(pa, vl[t2][db], oa[db], 0, 0, 0); }
                    __builtin_amdgcn_sched_barrier(0);
                    if (bt < 3) {
#pragma unroll
                        for (int t2 = 0; t2 < 2; ++t2)
#pragma unroll
                            for (int db = 0; db < 4; ++db) vl[t2][db] = *(const bf16x8*)(Vt + ((size_t)((b * 8 + hh) * 64 + db * 16 + fr)) * VTP + (rs + bt * 2 + 2 + t2) * 64 + cstart + 8 * fq);
                        __builtin_amdgcn_sched_barrier(0);
                    }
                }
#pragma unroll
                for (int t2 = 0; t2 < 2; ++t2) { const int t = bt * 2 + t2;
                    u32x4 pf; pf[0] = pk_bf16(sc[2 * t][0], sc[2 * t][1]); pf[1] = pk_bf16(sc[2 * t][2], sc[2 * t][3]); pf[2] = pk_bf16(sc[2 * t + 1][0], sc[2 * t + 1][1]); pf[3] = pk_bf16(sc[2 * t + 1][2], sc[2 * t + 1][3]);
                    const bf16x8 pa = __builtin_bit_cast(bf16x8, pf);
#pragma unroll
                    for (int db = 0; db < 4; ++db) {
                        const bf16x8 vv = *(const bf16x8*)(Vc + (db * 16 + fr) * VP + 32 * t + 8 * fq);
                        oa[db] = __builtin_amdgcn_mfma_f32_16x16x32_bf16(pa, vv, oa[db], 0, 0, 0);
                    } }
                __builtin_amdgcn_sched_barrier(0);
            }
            const float inv = 1.f / sum;
            u16* ot = (u16*)(shm + 256 * KP * 2 + 64 * VP * 2 + 2048) + w * (16 * 72);
#pragma unroll
            for (int j = 0; j < 4; ++j) { const float iv = __shfl(inv, fq * 4 + j, 64);
#pragma unroll
                for (int db = 0; db < 4; ++db) ot[(fq * 4 + j) * 72 + db * 16 + fr] = f2bf(oa[db][j] * iv); }
            __builtin_amdgcn_wave_barrier();
            { const int qq = lane >> 2, sg = (lane & 3) * 16;
              const u32x4 o0 = *(const u32x4*)(ot + qq * 72 + sg), o1 = *(const u32x4*)(ot + qq * 72 + sg + 8);
              u16* dst = O + (size_t)(qtok0 + qq) * KOUT + hh * 64 + sg;
              *(u32x4*)dst = o0; *(u32x4*)(dst + 8) = o1; }
            __builtin_amdgcn_wave_barrier();
        }
    }
    __syncthreads();
}

#define XB_TMO      128
#define XB_XCNT(j)  (256  + 64 * (j))
#define XB_XSUB(j)  (1280 + 64 * (j))
#define XB_XGEN(j)  (2304 + 64 * (j))
#define XB_TOP      3328
#define XB_TOPGEN   3392
#define XB_SPIN_CAP (1u << 18)
__device__ __forceinline__ unsigned xb_ld(unsigned* p)              { return __hip_atomic_load(p, __ATOMIC_RELAXED, __HIP_MEMORY_SCOPE_AGENT); }
__device__ __forceinline__ unsigned xb_add(unsigned* p, unsigned v) { return __hip_atomic_fetch_add(p, v, __ATOMIC_RELAXED, __HIP_MEMORY_SCOPE_AGENT); }
__device__ __forceinline__ unsigned xb_xcc_id() { return (unsigned)__builtin_amdgcn_s_getreg((3 << 11) | 20) & 0xFu; }
#define XB_SPIN(cond, bar) do { unsigned _sp = 0; while (cond) { __builtin_amdgcn_s_sleep(1); \
    if ((++_sp & 255u) == 0u) { if (xb_ld(&(bar)[XB_TMO])) break; if (_sp > XB_SPIN_CAP) { atomicAdd(&(bar)[XB_TMO], 1u); break; } } } } while (0)
__device__ __forceinline__ void xcd_barrier_complete(unsigned* bar, unsigned x, unsigned& nloc, unsigned& nx) {
    const unsigned G = gridDim.x * gridDim.y * gridDim.z;
    unsigned sum, cnt, mine, sp = 0u;
    for (;;) {
        sum = 0u; cnt = 0u; mine = 0u;
#pragma unroll
        for (unsigned j = 0; j < 16; ++j) { const unsigned c = xb_ld(&bar[XB_XCNT(j)]); sum += c; cnt += (c > 0u) ? 1u : 0u; mine = (j == x) ? c : mine; }
        if (sum == G) break;
        __builtin_amdgcn_s_sleep(1);
        if ((++sp & 255u) == 0u) { if (xb_ld(&bar[XB_TMO])) break; if (sp > XB_SPIN_CAP) { atomicAdd(&bar[XB_TMO], 1u); break; } }
    }
    nloc = mine > 0u ? mine : 1u; nx = cnt > 0u ? cnt : 1u;
}
__device__ __forceinline__ void xcd_barrier(volatile unsigned* st) {
    asm volatile("s_waitcnt vmcnt(0)" ::: "memory");
    __syncthreads();
    const Params p = kparams();
    unsigned* bar = (unsigned*)(p.ws + OFF_BAR);
    if (threadIdx.x == 0) {
        const unsigned x = xb_xcc_id();
        __builtin_amdgcn_s_waitcnt(0);
        unsigned nloc = st[0], nx = st[1];
        if (nloc == 0u) { xcd_barrier_complete(bar, x, nloc, nx); st[0] = nloc; st[1] = nx; }
        const unsigned old = xb_add(&bar[XB_XSUB(x)], 1u);
        const unsigned gen = old / nloc;
        if (old + 1u == (gen + 1u) * nloc) {
            __builtin_amdgcn_fence(__ATOMIC_RELEASE, "agent");
            asm volatile("s_waitcnt vmcnt(0)" ::: "memory");
            const unsigned og = xb_add(&bar[XB_TOP], 1u);
            const unsigned tg = og / nx;
            if (og + 1u == (tg + 1u) * nx) xb_add(&bar[XB_TOPGEN], 1u);
            else XB_SPIN(xb_ld(&bar[XB_TOPGEN]) == tg, bar);
            __builtin_amdgcn_fence(__ATOMIC_ACQUIRE, "agent");
            xb_add(&bar[XB_XGEN(x)], 1u);
            asm volatile("s_waitcnt vmcnt(0)" ::: "memory");
        } else {
            XB_SPIN(xb_ld(&bar[XB_XGEN(x)]) == gen, bar);
            __builtin_amdgcn_fence(__ATOMIC_ACQUIRE, "agent");
            asm volatile("s_waitcnt vmcnt(0)" ::: "memory");
        }
    }
    __syncthreads();
}

__global__ __launch_bounds__(NTHREADS, 2) void fwd_kernel(Params pk) {
    extern __shared__ __attribute__((aligned(16))) unsigned char shm[];
    cg::grid_group grid = cg::this_grid();
    LAS unsigned char* lds = (LAS unsigned char*)shm;
    volatile unsigned* xst = (volatile unsigned*)(shm + 150528);
    { const Params p = kparams(); unsigned* bar = (unsigned*)(p.ws + OFF_BAR);
      if (threadIdx.x == 0) { xst[0] = 0u; xst[1] = 0u; (void)xb_add(&bar[XB_XCNT(xb_xcc_id())], 1u); } }
    __syncthreads();
    phase0(shm);
    grid.sync();
    { const Params p = kparams(); ln_phase<0>(p.in[0], p.in[2], (_Float16*)(p.ws + OFF_X16), (float*)(p.ws + OFF_ST), nullptr, (u16*)(p.ws + OFF_O), nullptr, nullptr, (const float*)(p.ws + OFF_MOD), 0, TT); }
    for (int l = 0; l < DEPTH; ++l) {
        for (int st = 0; st < 3; ++st) {
            const int rows = (l == DEPTH - 1 && st == 2) ? TL : TT;
            if (st != 1) {
                const int f = st >> 1;
                xcd_barrier(xst);
                { const Params p = kparams(); const u16* wl = (const u16*)(p.ws + OFF_W) + (size_t)l * W_LAYER;
                  pg8::Gemm g{(const u16*)(p.ws + OFF_O), wl + (f ? W_GU2 : W_GU1), rows, 2 * DFF, DM, 0, 0, 0, 0, 0, nullptr, 0}; EpiGU e{(u16*)(p.ws + OFF_H)}; pg8::gemm_phase(lds, g, e); }
                xcd_barrier(xst);
                const bool split = (rows == TT);
#pragma nounroll
                for (int part = 0; part < 2; ++part) {
                    if (part == 1) { if (!split) break; xcd_barrier(xst); }
                    { const Params p = kparams(); const u16* wl = (const u16*)(p.ws + OFF_W) + (size_t)l * W_LAYER;
                      pg8::Gemm g{(const u16*)(p.ws + OFF_H), wl + (f ? W_D2 : W_D1), rows, DM, DFF, 0, 1, 0, part ? 1024 : 0, part ? 32 : 1024, nullptr, 0};
                      const int pl = l * 3 + st - 1;
                      const float* lg = pl < 0 ? (const float*)(p.ws + OFF_ID) : p.in[6] + (size_t)pl * DM; const float* lb = pl < 0 ? (const float*)(p.ws + OFF_ID) + DM : p.in[7] + (size_t)pl * DM;
                      EpiRes e{(_Float16*)(p.ws + OFF_X16), (const float*)(p.ws + OFF_ST), lg, lb, (const float*)(p.ws + OFF_MOD) + (size_t)l * 9 * NMOD, 3 * st + 2, 0.5f}; pg8::gemm_phase(lds, g, e); }
                    if (part == 1) { const Params p = kparams(); const int nl = (st == 2) ? l + 1 : l, nsub = (st == 2) ? 0 : 1;
                        ln_phase<1>(nullptr, nullptr, (_Float16*)(p.ws + OFF_X16), (float*)(p.ws + OFF_ST), nullptr, (u16*)(p.ws + OFF_O), p.in[6] + (size_t)(l * 3 + st) * DM, p.in[7] + (size_t)(l * 3 + st) * DM,
                                    (const float*)(p.ws + OFF_MOD) + (size_t)nl * 9 * NMOD, nsub, TL, 0, 32); }
                }
                xcd_barrier(xst);
                { const Params p = kparams();
                  const float* gg = p.in[6] + (size_t)(l * 3 + st) * DM; const float* bb = p.in[7] + (size_t)(l * 3 + st) * DM;
                  if (!split) ln_phase<2>(nullptr, nullptr, (_Float16*)(p.ws + OFF_X16), nullptr, p.out, nullptr, gg, bb, nullptr, 0, TL);
                  else { const int nl = (st == 2) ? l + 1 : l, nsub = (st == 2) ? 0 : 1;
                         ln_phase<1>(nullptr, nullptr, (_Float16*)(p.ws + OFF_X16), (float*)(p.ws + OFF_ST), nullptr, (u16*)(p.ws + OFF_O), gg, bb, (const float*)(p.ws + OFF_MOD) + (size_t)nl * 9 * NMOD, nsub, TT, TL, 0); } }
            } else {
                const int orows = (l == DEPTH - 1) ? TL : TT;
                xcd_barrier(xst);
                { const Params p = kparams(); const u16* wl = (const u16*)(p.ws + OFF_W) + (size_t)l * W_LAYER;
                  pg8::Gemm g{(const u16*)(p.ws + OFF_O), wl + W_IN, TT, NIN, DM, 0, 0, 0, 0, 0, nullptr, 0}; EpiIn e{(u16*)(p.ws + OFF_P), (u16*)(p.ws + OFF_VT), (u16*)(p.ws + OFF_VTC), (u16*)(p.ws + OFF_FT), (u16*)(p.ws + OFF_FTC)}; pg8::gemm_phase(lds, g, e); }
                xcd_barrier(xst);
                ft_fold();
                lru_pass<false>(l, shm);
                xcd_barrier(xst);
                lru_prefix();
#pragma nounroll
                for (int wh = 0; wh < ((l == DEPTH - 1) ? 1 : 2); ++wh) { const Params p = kparams();
                  pg8::Gemm g{(const u16*)(p.ws + (wh ? OFF_DFTC : OFF_DFT)), (const u16*)(p.ws + (wh ? OFF_FTC : OFF_GE)), wh ? 256 : 8192, NB * 256, wh ? CTXL : 4096, 0, wh ? 0 : 1, wh ? 0 : 1, 0, 0,
                              wh ? (const u16*)nullptr : (const u16*)(p.ws + OFF_GO), 16};
                  EpiDft e{(u16*)(p.ws + OFF_O), wh ? TL : 0, wh ? 7 : 12, wh ? CTXL : SEQ, wh ? 0 : 1}; pg8::gemm_phase(lds, g, e); }
                xcd_barrier(xst);
                lru_apply();
                attn_phase(l, shm);
                xcd_barrier(xst);
                const bool osplit = (orows == TT);
#pragma nounroll
                for (int part = 0; part < 2; ++part) {
                    if (part == 1) { if (!osplit) break; xcd_barrier(xst); }
                    { const Params p = kparams(); const u16* wl = (const u16*)(p.ws + OFF_W) + (size_t)l * W_LAYER;
                      pg8::Gemm g{(const u16*)(p.ws + OFF_O), wl + W_OUT, orows, DM, KOUT, 0, 0, 0, part ? 1024 : 0, part ? 32 : 1024, nullptr, 0};
                      EpiRes e{(_Float16*)(p.ws + OFF_X16), (const float*)(p.ws + OFF_ST), p.in[6] + (size_t)(l * 3) * DM, p.in[7] + (size_t)(l * 3) * DM, (const float*)(p.ws + OFF_MOD) + (size_t)l * 9 * NMOD, 5, 1.0f}; pg8::gemm_phase(lds, g, e); }
                    if (part == 1) { const Params p = kparams();
                        ln_phase<1>(nullptr, nullptr, (_Float16*)(p.ws + OFF_X16), (float*)(p.ws + OFF_ST), nullptr, (u16*)(p.ws + OFF_O), p.in[6] + (size_t)(l * 3 + 1) * DM, p.in[7] + (size_t)(l * 3 + 1) * DM,
                                    (const float*)(p.ws + OFF_MOD) + (size_t)l * 9 * NMOD, 2, TL, 0, 32); }
                }
                xcd_barrier(xst);
                { const Params p = kparams();
                  ln_phase<1>(nullptr, nullptr, (_Float16*)(p.ws + OFF_X16), (float*)(p.ws + OFF_ST), nullptr, (u16*)(p.ws + OFF_O), p.in[6] + (size_t)(l * 3 + 1) * DM, p.in[7] + (size_t)(l * 3 + 1) * DM,
                              (const float*)(p.ws + OFF_MOD) + (size_t)l * 9 * NMOD, 2, orows, osplit ? TL : 0, 0); }
            }
        }
    }
}

extern "C" void kernel_launch(void* const* d_in, const int* in_sizes, int n_in, void* d_out, int out_size, void* d_ws, size_t ws_size, hipStream_t stream) {
    static int grid = 0;
    if (grid == 0) {
        if (n_in != 25 || out_size != TL * DM || ws_size < WS_END) { fprintf(stderr, "kernel_launch: unexpected shapes (n_in %d out %d ws %zu need %zu)\n", n_in, out_size, ws_size, (size_t)WS_END); grid = -1; return; }
        int dev = 0, cus = 0, per_cu = 0;
        hipGetDevice(&dev);
        hipDeviceGetAttribute(&cus, hipDeviceAttributeMultiprocessorCount, dev);
        hipFuncSetAttribute((const void*)fwd_kernel, hipFuncAttributeMaxDynamicSharedMemorySize, LDS_BYTES);
        hipOccupancyMaxActiveBlocksPerMultiprocessor(&per_cu, (const void*)fwd_kernel, NTHREADS, LDS_BYTES);
        if (per_cu < 1) per_cu = 1;
        if (per_cu > 1) per_cu = 1;
        (void)hipGetLastError();
        grid = cus * per_cu;
    }
    if (grid < 0) return;
    if (hipMemsetAsync((char*)d_ws + OFF_BAR, 0, (size_t)XCD_BAR_WORDS * 4, stream) != hipSuccess) { fprintf(stderr, "kernel_launch: memset of the barrier words failed\n"); return; }
    Params p{};
    for (int i = 0; i < 25; ++i) p.in[i] = (const float*)d_in[i];
    p.out = (float*)d_out; p.ws = (unsigned char*)d_ws;
    void* args[] = {&p};
    hipError_t e = hipLaunchCooperativeKernel((const void*)fwd_kernel, dim3(grid), dim3(NTHREADS), args, LDS_BYTES, stream);
    if (e != hipSuccess) fprintf(stderr, "cooperative launch failed: %s (grid %d)\n", hipGetErrorString(e), grid);
}
```

```cpp
#include <hip/hip_runtime.h>
#include <hip/hip_cooperative_groups.h>
#include <cstdio>
namespace cg = cooperative_groups;

#define LAS __attribute__((address_space(3)))
typedef unsigned short u16;
typedef short bf16x8 __attribute__((ext_vector_type(8)));
typedef float f32x4 __attribute__((ext_vector_type(4)));
typedef unsigned u32x4 __attribute__((ext_vector_type(4)));
typedef unsigned u32x2 __attribute__((ext_vector_type(2)));
typedef _Float16 h16x4 __attribute__((ext_vector_type(4)));
typedef _Float16 h16x8 __attribute__((ext_vector_type(8)));
typedef float f32x8 __attribute__((ext_vector_type(8)));

constexpr int DM = 1024, NB = 8, SEQ = 8192, DEPTH = 4, CTXL = 256;
constexpr int TL = NB * SEQ, TC = NB * CTXL, TT = TL + TC;
constexpr int DFF = 2816, NIN = 2304, KOUT = 1280, NMOD = 9216;
constexpr float ALPHA = 1.681792830507429f;
constexpr float LN_EPS = 1e-5f;
constexpr int NTHREADS = 512;
constexpr int LDS_BYTES = 151552;

constexpr size_t OFF_H    = 0;
constexpr size_t OFF_P    = 0;
constexpr size_t OFF_VT   = (size_t)TT * NIN * 2;
constexpr size_t OFF_O    = (size_t)TT * DFF * 2;
constexpr size_t OFF_FT   = OFF_O + (size_t)TT * KOUT * 2;
constexpr size_t OFF_FTC  = OFF_FT + (size_t)NB * 256 * SEQ * 2;
constexpr size_t OFF_W    = OFF_FTC + (size_t)NB * 256 * CTXL * 2;
constexpr size_t W_GU1 = 0, W_D1 = 5767168, W_GU2 = 8650752, W_D2 = 14417920, W_IN = 17301504, W_OUT = 19660800, W_LAYER = 20971520;
constexpr size_t OFF_DFT  = OFF_W + W_LAYER * 2 * DEPTH;
constexpr size_t OFF_GE   = OFF_DFT + (size_t)8192 * 4096 * 2;
constexpr size_t OFF_GO   = OFF_GE + (size_t)NB * 256 * 4096 * 2;
constexpr size_t OFF_DFTC = OFF_DFT + (size_t)8192 * 8192 * 2;
constexpr size_t OFF_XC   = OFF_DFTC + (size_t)256 * 256 * 2;
constexpr size_t OFF_ST   = OFF_XC;
constexpr size_t OFF_ID   = OFF_XC + (size_t)TT * 8;
constexpr size_t OFF_MOD  = OFF_XC + (size_t)TC * DM * 4;
constexpr size_t OFF_LRU  = OFF_MOD + (size_t)DEPTH * 9 * NMOD * 4;
constexpr size_t OFF_CAR  = OFF_LRU + (size_t)NB * 264 * 2 * 256 * 8;
constexpr size_t OFF_LW   = OFF_CAR + (size_t)NB * 264 * 2 * 256 * 4;
constexpr size_t OFF_X16  = OFF_LW + (size_t)DEPTH * 16 * 4096 * 2;
constexpr size_t OFF_BAR  = OFF_X16 + (size_t)TT * DM * 2;
constexpr int XCD_BAR_WORDS = 3456;
constexpr size_t WS_END   = OFF_BAR + (size_t)XCD_BAR_WORDS * 4;
constexpr int VTP = SEQ + 64;
constexpr size_t OFF_VTC = OFF_XC + (size_t)(1 << 20);
static_assert((size_t)NB * 8 * 64 * VTP * 2 <= (size_t)TT * 512 * 2, "padded V^T must fit behind P");
static_assert((size_t)TT * 8 + 2 * DM * 4 <= (size_t)(1 << 20) && (size_t)(1 << 20) + (size_t)NB * 8 * 64 * CTXL * 2 <= (size_t)TC * DM * 4, "spare region layout");

struct Params {
    const float* in[25];
    float* out;
    unsigned char* ws;
};

typedef const __attribute__((address_space(4))) Params* KParamsPtr;
#if defined(__HIP_DEVICE_COMPILE__)
__device__ __forceinline__ Params kparams() { KParamsPtr k = (KParamsPtr)__builtin_amdgcn_kernarg_segment_ptr(); asm volatile("" : "+s"(k)); Params r; for (int i = 0; i < 25; ++i) r.in[i] = k->in[i]; r.out = k->out; r.ws = k->ws; return r; }
#else
__device__ __forceinline__ Params kparams() { return Params{}; }
#endif
__device__ __forceinline__ u16 f2bf(float f) { unsigned u = __float_as_uint(f); u += 0x7FFFu + ((u >> 16) & 1u); return (u16)(u >> 16); }
__device__ __forceinline__ float bf2f(u16 b) { return __uint_as_float(((unsigned)b) << 16); }
__device__ __forceinline__ unsigned pk_bf16(float lo, float hi) { unsigned r; asm volatile("v_cvt_pk_bf16_f32 %0, %1, %2" : "=v"(r) : "v"(lo), "v"(hi)); return r; }
__device__ __forceinline__ int opaque_tid() { int t = threadIdx.x; asm volatile("" : "+v"(t)); return t; }
__device__ __forceinline__ float silu_f(float v) { return v * __builtin_amdgcn_rcpf(1.f + __expf(-v)); }
__device__ __forceinline__ float sigmoid_f(float v) { return __builtin_amdgcn_rcpf(1.f + __expf(-v)); }
__device__ __forceinline__ float gelu_tanh(float x) {
    const float w = x * (2.3022081986f + 0.1029432396f * x * x);
    return x - x * __builtin_amdgcn_rcpf(1.f + __builtin_amdgcn_exp2f(w)); }

namespace pg8 {
constexpr int BM = 256, BK = 64, HALF = 128, HTB = HALF * BK * 2, NXCD = 8, WGM = 8;
__device__ __forceinline__ int lds_byte(int r, int c) { const int st = (r >> 4) * 2 + (c >> 5), rr = r & 15, cc = c & 31, ob = rr * 64 + cc * 2; return st * 1024 + (ob ^ (((ob >> 9) & 1) << 5)); }
__device__ __forceinline__ void stage_rc(int b, int& R, int& C) { const int st = b / 1024, sb = b % 1024, swz = sb ^ (((sb >> 9) & 1) << 5); R = (st >> 1) * 16 + swz / 64; C = (st & 1) * 32 + (swz % 64) / 2; }
__device__ __forceinline__ int perm32(int rho) { const int n = rho >> 4, i = rho & 15; return 8 * (i >> 2) + 4 * n + (i & 3); }
struct Unit { int pm, pn; };
struct Gemm { const u16* A; const u16* Bt; int M, N, K; int rev; int ablk, bblk; int ubase, ucount; const u16* Bt2; int bsplit; };
struct StaticOrder {
    int nM, nN, nwg, G, c, rev, ubase, ulimit;
    __device__ void init(int M, int N, int G_, int c_, int rev_, int ubase_, int ucount_) { nM = M / BM; nN = N / BM; nwg = nM * nN; G = G_; c = c_; rev = rev_; ubase = ubase_; ulimit = ucount_ > 0 ? ubase_ + ucount_ : 0; }
    __device__ bool next(int i, Unit& u) const {
        if (ulimit) {
            const int L = ubase + i * G + c; if (L >= ulimit) return false;
            if (L < 1024) { const int rd = L >> 8, cc = L & 255, j = cc >> 3; u.pm = rd * 64 + (cc & 7) * 8 + (j & 7); u.pn = j >> 3; }
            else { const int t = L - 1024; u.pm = 256 + (t & 7); u.pn = t >> 3; }
            return true;
        }
        const long L = (long)i * G + c; if (L >= nwg) return false;
        int wgid = (int)L; { const int q = nwg / NXCD, r = nwg % NXCD, xcd = wgid % NXCD, off = wgid / NXCD; wgid = (xcd < r ? xcd * (q + 1) : r * (q + 1) + (xcd - r) * q) + off; }
        const int nig = WGM * nN, gid = wgid / nig, fm = gid * WGM, gsz = (nM - fm) < WGM ? (nM - fm) : WGM;
        u.pm = fm + ((wgid % nig) % gsz); u.pn = (wgid % nig) / gsz; if (rev) u.pm = nM - 1 - u.pm; return true;
    }
};

template <class Epi>
__device__ __forceinline__ void gemm_phase(LAS unsigned char* lds, const Gemm g, const Epi& E) {
    __builtin_amdgcn_sched_barrier(0);
    const int tid = opaque_tid(), wid = __builtin_amdgcn_readfirstlane(tid >> 6), lane = tid & 63, wr = wid >> 2, wc = wid & 3, fr = lane & 15, fq = lane >> 4;
    const int K = g.K, nt = K / BK;
    StaticOrder S; S.init(g.M, g.N, (int)gridDim.x, (int)blockIdx.x, g.rev, g.ubase, g.ucount);
    unsigned voffA[2], voffB[2];
#pragma unroll
    for (int i = 0; i < 2; ++i) { int R, C; stage_rc(tid * 16 + i * 8192, R, C); const int Rb = Epi::PERM ? ((R & ~31) + perm32(R & 31)) : R;
        voffA[i] = (unsigned)(R * (g.ablk ? BK : K) + C) * 2u; voffB[i] = (unsigned)(Rb * (g.bblk ? BK : K) + C) * 2u; }
    const size_t tstep = (size_t)BM * K * 2;
    const size_t kstA = g.ablk ? (size_t)(BM * BK * 2) : (size_t)(BK * 2), kstB = g.bblk ? (size_t)(BM * BK * 2) : (size_t)(BK * 2);
    const size_t hstA = g.ablk ? (size_t)(HALF * BK * 2) : (size_t)HALF * K * 2, hstB = g.bblk ? (size_t)(HALF * BK * 2) : (size_t)HALF * K * 2;
    const unsigned ldsw = (unsigned)wid * 1024u;
    const int aoff = lds_byte(wr * 64 + fr, fq * 8), boff = lds_byte(wc * 32 + fr, fq * 8);
#define PG8_SA(b, h) (((b) * 2 + (h)) * HTB)
#define PG8_SB(b, h) ((4 + (b) * 2 + (h)) * HTB)
#define PG8_STAGE(bufoff, gbase, voff) do { _Pragma("unroll") for (int _i = 0; _i < 2; ++_i) \
        __builtin_amdgcn_global_load_lds((const unsigned*)((const char*)(gbase) + (voff)[_i]), (LAS unsigned*)(lds + (bufoff) + ldsw + _i * 8192), 16, 0, 0); } while (0)
#define PG8_LDA(dst, b, h) do { _Pragma("unroll") for (int m = 0; m < 4; ++m) _Pragma("unroll") for (int k = 0; k < 2; ++k) dst[m][k] = *(const LAS bf16x8*)(lds + PG8_SA(b, h) + aoff + m * 2048 + k * 1024); } while (0)
#define PG8_LDB(dst, b, h) do { _Pragma("unroll") for (int n = 0; n < 2; ++n) _Pragma("unroll") for (int k = 0; k < 2; ++k) dst[n][k] = *(const LAS bf16x8*)(lds + PG8_SB(b, h) + boff + n * 2048 + k * 1024); } while (0)
#define PG8_MMA(ai, bj, At, Bt) do { __builtin_amdgcn_s_setprio(1); _Pragma("unroll") for (int m = 0; m < 4; ++m) _Pragma("unroll") for (int n = 0; n < 2; ++n) _Pragma("unroll") for (int k = 0; k < 2; ++k) \
        acc[ai][bj][m][n] = __builtin_amdgcn_mfma_f32_16x16x32_bf16(Bt[n][k], At[m][k], acc[ai][bj][m][n], 0, 0, 0); __builtin_amdgcn_s_setprio(0); } while (0)
#define PG8_WAIT_V(n) asm volatile("s_waitcnt vmcnt(" #n ")" ::: "memory")
#define PG8_WAIT_L(n) asm volatile("s_waitcnt lgkmcnt(" #n ")" ::: "memory")
#define PG8_BAR __builtin_amdgcn_s_barrier()
#define PG8_SCHED __builtin_amdgcn_sched_barrier(0)
    Unit cur, nxt; int ui = 0;
    if (!S.next(0, cur)) return;
    f32x4 acc[2][2][4][2];
#pragma unroll
    for (int a = 0; a < 2; ++a)
#pragma unroll
        for (int b = 0; b < 2; ++b)
#pragma unroll
            for (int m = 0; m < 4; ++m)
#pragma unroll
                for (int n = 0; n < 2; ++n) acc[a][b][m][n] = (f32x4){0.f, 0.f, 0.f, 0.f};
    bf16x8 At[4][2], B0[2][2], B1[2][2];
    const char* cA = (const char*)g.A + (size_t)cur.pm * tstep; const char* cB = (const char*)((g.Bt2 && cur.pm >= g.bsplit) ? g.Bt2 : g.Bt) + (size_t)cur.pn * tstep;
    PG8_STAGE(PG8_SB(0, 0), cB, voffB); PG8_STAGE(PG8_SA(0, 0), cA, voffA); PG8_STAGE(PG8_SB(0, 1), cB + hstB, voffB); PG8_STAGE(PG8_SA(0, 1), cA + hstA, voffA);
    if (wr == 1) PG8_BAR;
    PG8_WAIT_V(4); PG8_BAR;
    PG8_STAGE(PG8_SB(1, 0), cB + kstB, voffB); PG8_STAGE(PG8_SA(1, 0), cA + kstA, voffA); PG8_STAGE(PG8_SB(1, 1), cB + hstB + kstB, voffB);
    PG8_WAIT_V(6); PG8_BAR;
    for (;;) {
        const bool has_next = S.next(ui + 1, nxt);
        const char* nA = has_next ? (const char*)g.A + (size_t)nxt.pm * tstep : cA; const char* nB = has_next ? (const char*)((g.Bt2 && nxt.pm >= g.bsplit) ? g.Bt2 : g.Bt) + (size_t)nxt.pn * tstep : cB;
        for (int t = 0; t < nt; t += 2) {
            const bool last = (t == nt - 2);
            const char* a1 = cA + (size_t)(t + 1) * kstA;
            const char* a2 = last ? nA : cA + (size_t)(t + 2) * kstA; const char* b2 = last ? nB : cB + (size_t)(t + 2) * kstB;
            const char* a3 = a2 + kstA; const char* b3 = b2 + kstB;
            PG8_LDB(B0, 0, 0); PG8_SCHED; PG8_LDA(At, 0, 0); PG8_STAGE(PG8_SA(1, 1), a1 + hstA, voffA);
            PG8_WAIT_L(8); PG8_BAR; PG8_WAIT_L(0); PG8_MMA(0, 0, At, B0); PG8_BAR; PG8_SCHED;
            PG8_LDB(B1, 0, 1); PG8_STAGE(PG8_SB(0, 0), b2, voffB);
            PG8_BAR; PG8_WAIT_L(0); PG8_MMA(0, 1, At, B1); PG8_BAR;
            PG8_LDA(At, 0, 1); PG8_STAGE(PG8_SA(0, 0), a2, voffA);
            PG8_BAR; PG8_WAIT_L(0); PG8_MMA(1, 0, At, B0); PG8_BAR; PG8_SCHED;
            PG8_STAGE(PG8_SB(0, 1), b2 + hstB, voffB);
            PG8_WAIT_V(6); PG8_BAR; PG8_MMA(1, 1, At, B1); PG8_BAR;
            PG8_LDB(B0, 1, 0); PG8_SCHED; PG8_LDA(At, 1, 0); PG8_STAGE(PG8_SA(0, 1), a2 + hstA, voffA);
            PG8_WAIT_L(8); PG8_BAR; PG8_WAIT_L(0); PG8_MMA(0, 0, At, B0); PG8_BAR; PG8_SCHED;
            PG8_LDB(B1, 1, 1); PG8_STAGE(PG8_SB(1, 0), b3, voffB);
            PG8_BAR; PG8_WAIT_L(0); PG8_MMA(0, 1, At, B1); PG8_BAR;
            PG8_LDA(At, 1, 1); PG8_STAGE(PG8_SA(1, 0), a3, voffA);
            PG8_BAR; PG8_WAIT_L(0); PG8_MMA(1, 0, At, B0); PG8_BAR; PG8_SCHED;
            PG8_STAGE(PG8_SB(1, 1), b3 + hstB, voffB);
            PG8_WAIT_V(6); PG8_BAR; PG8_MMA(1, 1, At, B1); PG8_BAR;
        }
        E(acc, cur, wr, wc, fr, fq);
        if (!has_next) break;
#pragma unroll
        for (int a = 0; a < 2; ++a)
#pragma unroll
            for (int b = 0; b < 2; ++b)
#pragma unroll
                for (int m = 0; m < 4; ++m)
#pragma unroll
                    for (int n = 0; n < 2; ++n) acc[a][b][m][n] = (f32x4){0.f, 0.f, 0.f, 0.f};
        cur = nxt; cA = nA; cB = nB; ++ui;
    }
    PG8_WAIT_V(0);
    if (wr == 0) PG8_BAR;
    PG8_BAR;
    PG8_SCHED;
#undef PG8_SA
#undef PG8_SB
#undef PG8_STAGE
#undef PG8_LDA
#undef PG8_LDB
#undef PG8_MMA
#undef PG8_WAIT_V
#undef PG8_WAIT_L
#undef PG8_BAR
#undef PG8_SCHED
}
}
using pg8::Unit;
typedef f32x4 AccT[2][2][4][2];

struct EpiGU {
    static constexpr bool PERM = true;
    u16* H;
    __device__ __forceinline__ void operator()(const AccT& acc, const Unit& u, int wr, int wc, int fr_, int fq) const {
        int fr = fr_; asm volatile("" : "+v"(fr));
        const int rl = wr * 64 + fr, hc = u.pn * 128 + wc * 32 + 8 * fq;
#pragma unroll
        for (int ai = 0; ai < 2; ++ai)
#pragma unroll
            for (int m = 0; m < 4; ++m) {
                const f32x4 g0 = acc[ai][0][m][0], g1 = acc[ai][0][m][1], u0 = acc[ai][1][m][0], u1 = acc[ai][1][m][1];
                u32x4 o;
                o[0] = pk_bf16(silu_f(g0[0]) * u0[0], silu_f(g0[1]) * u0[1]); o[1] = pk_bf16(silu_f(g0[2]) * u0[2], silu_f(g0[3]) * u0[3]);
                o[2] = pk_bf16(silu_f(g1[0]) * u1[0], silu_f(g1[1]) * u1[1]); o[3] = pk_bf16(silu_f(g1[2]) * u1[2], silu_f(g1[3]) * u1[3]);
                __builtin_nontemporal_store(o, (u32x4*)(H + (size_t)u.pm * (256 * DFF) + (size_t)(hc >> 6) * 16384 + (size_t)(rl + ai * 128 + m * 16) * 64 + (hc & 63)));
            }
    }
};
struct EpiRes {
    static constexpr bool PERM = false;
    _Float16* X; const float* stats; const float* lg; const float* lb; const float* mods_l; int gate_idx; float coef;
    __device__ __forceinline__ void operator()(AccT& acc, const Unit& u, int wr, int wc, int fr_, int fq) const {
        int fr = fr_; asm volatile("" : "+v"(fr));
        const int row0 = u.pm * 256 + wr * 64 + fr, col0 = u.pn * 256 + wc * 32 + 4 * fq;
        const int s = (u.pm >= (TL / 256)) ? 8 : (u.pm >> 5);
        const float* gate = mods_l + (size_t)s * NMOD + gate_idx * DM + col0;
        _Float16* xb = X + (size_t)row0 * DM + col0;
        f32x4 gl[2][2];
#pragma unroll
        for (int bj = 0; bj < 2; ++bj)
#pragma unroll
            for (int n = 0; n < 2; ++n) {
                const f32x4 gv = *(const f32x4*)(gate + bj * 128 + n * 16) * coef, bl = *(const f32x4*)(lb + col0 + bj * 128 + n * 16) * ALPHA;
                gl[bj][n] = *(const f32x4*)(lg + col0 + bj * 128 + n * 16) * ALPHA;
#pragma unroll
                for (int ai = 0; ai < 2; ++ai)
#pragma unroll
                    for (int m = 0; m < 4; ++m) acc[ai][bj][m][n] = gv * acc[ai][bj][m][n] + bl; }
        __builtin_amdgcn_sched_barrier(0);
#pragma unroll
        for (int ai = 0; ai < 2; ++ai) {
            h16x4 xv[4][2][2]; float2 st[4];
#pragma unroll
            for (int m = 0; m < 4; ++m) { st[m] = *(const float2*)(stats + (size_t)(row0 + ai * 128 + m * 16) * 2);
#pragma unroll
                for (int bj = 0; bj < 2; ++bj)
#pragma unroll
                    for (int n = 0; n < 2; ++n) xv[m][bj][n] = *(const h16x4*)(xb + (size_t)(ai * 128 + m * 16) * DM + bj * 128 + n * 16); }
            __builtin_amdgcn_sched_barrier(0);
#pragma unroll
            for (int m = 0; m < 4; ++m)
#pragma unroll
                for (int bj = 0; bj < 2; ++bj)
#pragma unroll
                    for (int n = 0; n < 2; ++n) { const h16x4 xh = xv[m][bj][n]; const f32x4 a = acc[ai][bj][m][n]; h16x4 o;
#pragma unroll
                        for (int e = 0; e < 4; ++e) o[e] = (_Float16)((((float)xh[e] - st[m].x) * st[m].y) * gl[bj][n][e] + a[e]);
                        *(h16x4*)(xb + (size_t)(ai * 128 + m * 16) * DM + bj * 128 + n * 16) = o; }
            __builtin_amdgcn_sched_barrier(0);
        }
    }
};
struct EpiIn {
    static constexpr bool PERM = true;
    u16* P; u16* Vt; u16* Vtc; u16* Ft; u16* Ftc;
    __device__ __forceinline__ void operator()(const AccT& acc, const Unit& u, int wr, int wc, int fr_, int fq) const {
        int fr = fr_; asm volatile("" : "+v"(fr));
        const int row0 = u.pm * 256 + wr * 64 + fr;
        const bool isctx = u.pm >= (TL / 256);
        const int pn = u.pn;
        if (pn == 4 || pn == 5 || pn == 8) {
#pragma unroll
            for (int ai = 0; ai < 2; ++ai)
#pragma unroll
                for (int m = 0; m < 4; ++m) {
                    const int r = row0 + ai * 128 + m * 16;
#pragma unroll
                    for (int bj = 0; bj < 2; ++bj) {
                        const int c = pn * 256 + bj * 128 + wc * 32 + 8 * fq;
                        u16* dst; size_t stride;
                        if (pn == 8) { const int ch = c - 2048;
                            if (isctx) { const int rr = r - TL; dst = Ftc + ((size_t)((rr >> 8) * 256 + ch)) * CTXL + (rr & 255); stride = CTXL; }
                            else { const int n = r & 8191; dst = Ft + (size_t)(r >> 13) * (256 * SEQ) + (size_t)(n >> 6) * 16384 + ch * 64 + (n & 63); stride = 64; }
                        } else { const int hd = c - 1024;
                            if (isctx) { const int rr = r - TL; dst = Vtc + ((size_t)((rr >> 8) * 512 + hd)) * CTXL + (rr & 255); stride = CTXL; }
                            else { dst = Vt + ((size_t)((r >> 13) * 512 + hd)) * VTP + (r & 8191); stride = VTP; }
                        }
#pragma unroll
                        for (int n = 0; n < 2; ++n)
#pragma unroll
                            for (int e = 0; e < 4; ++e) dst[(size_t)(n * 4 + e) * stride] = f2bf(acc[ai][bj][m][n][e]);
                    }
                }
        } else {
            const float sc = pn < 2 ? 0.125f : 1.f;
#pragma unroll
            for (int ai = 0; ai < 2; ++ai)
#pragma unroll
                for (int m = 0; m < 4; ++m) {
                    u16* rowp = P + (size_t)(row0 + ai * 128 + m * 16) * NIN + pn * 256 + wc * 32 + 8 * fq;
#pragma unroll
                    for (int bj = 0; bj < 2; ++bj) { const f32x4 v0 = acc[ai][bj][m][0] * sc, v1 = acc[ai][bj][m][1] * sc;
                        u32x4 o; o[0] = pk_bf16(v0[0], v0[1]); o[1] = pk_bf16(v0[2], v0[3]); o[2] = pk_bf16(v1[0], v1[1]); o[3] = pk_bf16(v1[2], v1[3]);
                        *(u32x4*)(rowp + bj * 128) = o; }
                }
        }
    }
};
struct EpiDft {
    static constexpr bool PERM = true;
    u16* O; int tokbase; int nhl2; int nseq; int folded;
    __device__ __forceinline__ void operator()(const AccT& acc, const Unit& u, int wr, int wc, int fr_, int fq) const {
        int fr = fr_; asm volatile("" : "+v"(fr));
        const int NH = 1 << nhl2;
        const int b = u.pn;
#pragma unroll
        for (int bj = 0; bj < 2; ++bj) {
            const int ch = bj * 128 + wc * 32 + 8 * fq, g = ch >> 6, cgi = ch & 63;
            u16* ob = O + (size_t)(tokbase + b * nseq) * KOUT + 768 + g * 128 + cgi;
#pragma unroll
            for (int ai = 0; ai < 2; ++ai)
#pragma unroll
                for (int m = 0; m < 4; ++m) {
                    const int mrow = u.pm * 256 + ai * 128 + wr * 64 + m * 16 + fr;
                    const int s = folded ? ((mrow >> 11) & 1) : (mrow >> nhl2), k = folded ? (2 * (mrow & 2047) + (mrow >> 12)) : (mrow & (NH - 1));
                    const f32x4 v0 = acc[ai][bj][m][0], v1 = acc[ai][bj][m][1];
                    u32x4 o; o[0] = pk_bf16(v0[0], v0[1]); o[1] = pk_bf16(v0[2], v0[3]); o[2] = pk_bf16(v1[0], v1[1]); o[3] = pk_bf16(v1[2], v1[3]);
                    if (s == 0) { *(u32x4*)(ob + (size_t)k * KOUT) = o; if (k) *(u32x4*)(ob + (size_t)(nseq - k) * KOUT) = o; }
                    else if (k) { *(u32x4*)(ob + (size_t)k * KOUT + 64) = o;
                        o[0] ^= 0x80008000u; o[1] ^= 0x80008000u; o[2] ^= 0x80008000u; o[3] ^= 0x80008000u;
                        *(u32x4*)(ob + (size_t)(nseq - k) * KOUT + 64) = o; }
                    else { *(u32x4*)(ob + (size_t)NH * KOUT) = o; unsigned zz; asm volatile("v_mov_b32 %0, 0" : "=v"(zz)); const u32x4 z = {zz, zz, zz, zz};
                        *(u32x4*)(ob + 64) = z; *(u32x4*)(ob + (size_t)NH * KOUT + 64) = z; }
                    __builtin_amdgcn_sched_barrier(0);
                }
        }
    }
};

struct TrTile { const float* src; u16* dst; int spitch, dpitch; };
constexpr int TRL = 2496;
__device__ __forceinline__ TrTile tr_desc(const float* g1, const float* u1, const float* d1, const float* g2, const float* u2, const float* d2, const float* win, const float* wout, unsigned char* ws, int it) {
    const int l = it / TRL, ti = it % TRL;
    u16* wl = (u16*)(ws + OFF_W) + (size_t)l * W_LAYER;
    TrTile t;
    if (ti < 2112) {
        const int mi = ti / 352, tj = ti % 352, f = mi / 3, kind = mi % 3;
        if (kind < 2) { const int kt = tj / 22, ntl = tj % 22;
            const float* src = (f ? (kind ? u2 : g2) : (kind ? u1 : g1)) + (size_t)l * DM * DFF;
            t.src = src + (size_t)(kt * 64) * DFF + ntl * 128; t.spitch = DFF; t.dpitch = DM;
            t.dst = wl + (f ? W_GU2 : W_GU1) + (size_t)(256 * ntl + kind * 128) * DM + kt * 64;
        } else { const int kt = tj / 8, ntl = tj % 8;
            const float* src = (f ? d2 : d1) + (size_t)l * DFF * DM;
            t.src = src + (size_t)(kt * 64) * DM + ntl * 128; t.spitch = DM; t.dpitch = DFF;
            t.dst = wl + (f ? W_D2 : W_D1) + (size_t)(ntl * 128) * DFF + kt * 64; }
    } else if (ti < 2112 + 288) { const int tj = ti - 2112, kt = tj / 18, ntl = tj % 18;
        t.src = win + (size_t)l * DM * NIN + (size_t)(kt * 64) * NIN + ntl * 128; t.spitch = NIN; t.dpitch = DM;
        t.dst = wl + W_IN + (size_t)(ntl * 128) * DM + kt * 64;
    } else { const int tj = ti - 2400, kt = tj / 8, ntl = tj % 8;
        t.src = wout + (size_t)l * DM * DM + (size_t)(kt * 64) * DM + ntl * 128; t.spitch = DM; t.dpitch = KOUT;
        t.dst = wl + W_OUT + (size_t)(ntl * 128) * KOUT + kt * 64; }
    return t;
}

__device__ __forceinline__ void phase0(unsigned char* shm) {
    const Params p = kparams();
    const int tid = opaque_tid(), bid = blockIdx.x, nb = gridDim.x;
    float* sf = (float*)shm;
    float* mods = (float*)(p.ws + OFF_MOD);
    if (bid < 144) {
        float* sv = sf;
        float* red = sf + 9 * 1024;
        for (int i = tid; i < 9 * 1024; i += NTHREADS) { const int s = i >> 10, k = i & 1023; const float v = (s < 8) ? p.in[1][s * 1024 + k] : p.in[3][k]; sv[i] = silu_f(v); }
        __syncthreads();
        for (int item = bid; item < 144; item += nb) {
            const int l = item / 36, cgp = item % 36, cl = tid & 255, col = cgp * 256 + cl, kh = tid >> 8;
            const float* w = p.in[4] + (size_t)l * DM * NMOD + col;
            float a[9];
#pragma unroll
            for (int s = 0; s < 9; ++s) a[s] = 0.f;
#pragma unroll 16
            for (int k = kh * 512; k < kh * 512 + 512; ++k) { const float wv = w[(size_t)k * NMOD];
#pragma unroll
                for (int s = 0; s < 9; ++s) a[s] += sv[s * 1024 + k] * wv; }
            if (kh == 1) {
#pragma unroll
                for (int s = 0; s < 9; ++s) red[cl * 9 + s] = a[s]; }
            __syncthreads();
            if (kh == 0) { const float bb = p.in[5][l * NMOD + col];
#pragma unroll
                for (int s = 0; s < 9; ++s) mods[(size_t)(l * 9 + s) * NMOD + col] = a[s] + red[cl * 9 + s] + bb; }
            __syncthreads();
        }
    }
    __syncthreads();
    {
        float* tile = sf;
        const int ntile = DEPTH * TRL;
        f32x4 nv[4];
        const int kk0 = tid >> 5, n4 = tid & 31;
        int it = bid;
        if (it < ntile) { const TrTile t = tr_desc(p.in[8], p.in[9], p.in[10], p.in[11], p.in[12], p.in[13], p.in[14], p.in[15], p.ws, it);
#pragma unroll
            for (int i = 0; i < 4; ++i) nv[i] = *(const f32x4*)(t.src + (size_t)(kk0 + 16 * i) * t.spitch + n4 * 4); }
        for (; it < ntile; it += nb) {
            const TrTile t = tr_desc(p.in[8], p.in[9], p.in[10], p.in[11], p.in[12], p.in[13], p.in[14], p.in[15], p.ws, it);
#pragma unroll
            for (int i = 0; i < 4; ++i) { float* tp = tile + (kk0 + 16 * i) * 129 + n4 * 4; tp[0] = nv[i][0]; tp[1] = nv[i][1]; tp[2] = nv[i][2]; tp[3] = nv[i][3]; }
            __syncthreads();
            if (it + nb < ntile) { const TrTile tn = tr_desc(p.in[8], p.in[9], p.in[10], p.in[11], p.in[12], p.in[13], p.in[14], p.in[15], p.ws, it + nb);
#pragma unroll
                for (int i = 0; i < 4; ++i) nv[i] = *(const f32x4*)(tn.src + (size_t)(kk0 + 16 * i) * tn.spitch + n4 * 4); }
            { const int nn = tid >> 2, ks = (tid & 3) * 16;
#pragma unroll
              for (int hv = 0; hv < 2; ++hv) { u32x4 o;
#pragma unroll
                  for (int e = 0; e < 4; ++e) o[e] = pk_bf16(tile[(ks + hv * 8 + 2 * e) * 129 + nn], tile[(ks + hv * 8 + 2 * e + 1) * 129 + nn]);
                  *(u32x4*)(t.dst + (size_t)nn * t.dpitch + ks + hv * 8) = o; } }
            __syncthreads();
        }
    }
    {
        float* Mx = sf;
        float* ctab = sf + 8192;
        if (tid < 64) ctab[tid] = cospif((float)tid * (1.f / 32.f));
        __syncthreads();
        for (int it = nb - 1 - bid; it < DEPTH * 16; it += nb) {
            const int l = it >> 4, g = (it >> 2) & 3, jq = it & 3;
            const float* fw = p.in[24] + (size_t)(l * 4 + g) * 4096;
            for (int o = tid; o < 8192; o += NTHREADS) { const int kk = o >> 6, d = o & 63, c = kk & 63; float a = 0.f;
                for (int c2 = 0; c2 < 64; ++c2) { const int ph = (c * c2) & 63; const float tv = ctab[(kk < 64) ? ph : ((ph + 48) & 63)]; a += tv * fw[c2 * 64 + d]; }
                Mx[o] = a; }
            __syncthreads();
            { const int j = jq * 256 + (tid & 255), kkh = tid >> 8;
              const float* wo = p.in[15] + (size_t)l * DM * DM + (size_t)(768 + 64 * g) * DM + j;
              float a[64];
#pragma unroll
              for (int q = 0; q < 64; ++q) a[q] = 0.f;
              for (int d = 0; d < 64; ++d) { const float wv = wo[(size_t)d * DM];
#pragma unroll
                  for (int q = 0; q < 64; ++q) a[q] += Mx[(kkh * 64 + q) * 64 + d] * wv; }
              u16* dst = (u16*)(p.ws + OFF_W) + (size_t)l * W_LAYER + W_OUT + (size_t)j * KOUT + 768 + g * 128 + kkh * 64;
#pragma unroll
              for (int q8 = 0; q8 < 8; ++q8) { u32x4 o;
#pragma unroll
                  for (int e = 0; e < 4; ++e) o[e] = pk_bf16(a[q8 * 8 + 2 * e], a[q8 * 8 + 2 * e + 1]);
                  *(u32x4*)(dst + q8 * 8) = o; } }
            __syncthreads();
        }
    }
    if (bid == 0) { float* idv = (float*)(p.ws + OFF_ID); for (int i = tid; i < 2 * DM; i += NTHREADS) idv[i] = i < DM ? 1.f : 0.f; }
    { u16* lw = (u16*)(p.ws + OFF_LW);
      for (int i = bid * NTHREADS + tid; i < DEPTH * 16 * 4096; i += nb * NTHREADS) {
          const int c = i & 63, d = (i >> 6) & 63, hd = (i >> 12) & 3, gt = (i >> 14) & 1, ld = i >> 15;
          const float* src = gt ? p.in[21] : p.in[19];
          lw[i] = f2bf(src[((size_t)(ld * 4 + hd) * 64 + c) * 64 + d]); } }
    {
        u16* tab = (u16*)shm;
        const float scl = 0.001381067932004976f;
        for (int i = tid; i < 8192; i += NTHREADS) tab[i] = f2bf(scl * cospif((float)i * (1.f / 4096.f)));
        __syncthreads();
        u16* A = (u16*)(p.ws + OFF_DFT);
        for (int it = bid; it < 1024; it += nb) {
            for (int rr = 0; rr < 8; ++rr) { const int m = it * 8 + rr, blk = m >> 11, idx = m & 2047;
                const bool special = (blk == 1 && idx == 0);
                const int kk = special ? 4096 : 2 * idx + (blk >> 1), off = ((blk & 1) && !special) ? 2048 : 0;
                { const int n0 = tid * 8; u32x4 o;
#pragma unroll
                    for (int e = 0; e < 4; ++e) { const unsigned lo = tab[(kk * (n0 + 2 * e) + off) & 8191], hi = tab[(kk * (n0 + 2 * e + 1) + off) & 8191]; o[e] = lo | (hi << 16); }
                    *(u32x4*)(A + (size_t)(m >> 8) * (256 * 4096) + (size_t)(n0 >> 6) * 16384 + (m & 255) * 64 + (n0 & 63)) = o; } }
        }
        if (bid == nb - 1) { u16* Ac = (u16*)(p.ws + OFF_DFTC); const float sc = 0.0078125f;
            for (int i = tid; i < 65536; i += NTHREADS) { const int m = i >> 8, n = i & 255, kk = (m == 128) ? 128 : (m & 127); const float ang = (float)((kk * n) & 255) * (1.f / 128.f);
                Ac[i] = f2bf(m > 128 ? -sc * sinpif(ang) : sc * cospif(ang)); } }
        __syncthreads();
    }
}

__device__ __forceinline__ float wave_sum(float v) {
#pragma unroll
    for (int o = 32; o >= 1; o >>= 1) v += __shfl_xor(v, o, 64);
    return v;
}
constexpr int LNR = 4;
__device__ __forceinline__ f32x8 ld8f(const float* p) { const f32x4 a = *(const f32x4*)p, b = *(const f32x4*)(p + 4); return (f32x8){a[0], a[1], a[2], a[3], b[0], b[1], b[2], b[3]}; }
template <int MODE>
__device__ __forceinline__ void ln_phase(const float* src_lat, const float* src_ctx, _Float16* X, float* stats, float* outf, u16* h, const float* g, const float* bt, const float* mods_l, int sub, int nrows, int row_lo = 0, int blk_lo = 0) {
    const int tid = opaque_tid(), lane = tid & 63, gwv = ((int)blockIdx.x - blk_lo) * 8 + (tid >> 6);
    int nw = ((int)gridDim.x - blk_lo) * 8; asm volatile("" : "+s"(nw));
    if ((int)blockIdx.x < blk_lo) return;
    const int c0 = lane * 8;
    h16x8 nx[LNR][2];
    if (MODE != 0) { const int rf = row_lo + gwv * LNR;
        if (rf < nrows) {
#pragma unroll
            for (int j = 0; j < LNR; ++j)
#pragma unroll
                for (int i = 0; i < 2; ++i) nx[j][i] = *(const h16x8*)(X + (size_t)(rf + j) * DM + i * 512 + c0); }
    }
    for (int r0 = row_lo + gwv * LNR; r0 < nrows; r0 += LNR * nw) {
        f32x8 v[LNR][2]; int rr[LNR]; bool ok[LNR];
#pragma unroll
        for (int j = 0; j < LNR; ++j) { ok[j] = true; rr[j] = r0 + j; }
#pragma unroll
        for (int j = 0; j < LNR; ++j) {
            const int r = rr[j];
            if (MODE == 0) { const float* src = (r >= TL) ? src_ctx + (size_t)(r - TL) * DM : src_lat + (size_t)r * DM;
#pragma unroll
                for (int i = 0; i < 2; ++i) v[j][i] = ld8f(src + i * 512 + c0);
            } else {
#pragma unroll
                for (int i = 0; i < 2; ++i) { const h16x8 t = nx[j][i];
#pragma unroll
                    for (int e = 0; e < 8; ++e) v[j][i][e] = (float)t[e]; }
            }
        }
        if (MODE != 0) {
            const int rn0 = r0 + LNR * nw;
            if (rn0 < nrows) {
#pragma unroll
                for (int j = 0; j < LNR; ++j)
#pragma unroll
                    for (int i = 0; i < 2; ++i) nx[j][i] = *(const h16x8*)(X + (size_t)(rn0 + j) * DM + i * 512 + c0); }
        }
        float mean[LNR], rstd[LNR];
#pragma unroll
        for (int j = 0; j < LNR; ++j) { mean[j] = 0.f; rstd[j] = 1.f; }
        if (MODE != 0) {
#pragma unroll
            for (int j = 0; j < LNR; ++j) { float sm = 0.f;
#pragma unroll
                for (int i = 0; i < 2; ++i)
#pragma unroll
                    for (int e = 0; e < 8; ++e) sm += v[j][i][e];
                mean[j] = sm; }
#pragma unroll
            for (int o = 32; o >= 1; o >>= 1)
#pragma unroll
                for (int j = 0; j < LNR; ++j) mean[j] += __shfl_xor(mean[j], o, 64);
#pragma unroll
            for (int j = 0; j < LNR; ++j) { mean[j] *= (1.f / 1024.f); float sq = 0.f;
#pragma unroll
                for (int i = 0; i < 2; ++i)
#pragma unroll
                    for (int e = 0; e < 8; ++e) { const float d = v[j][i][e] - mean[j]; v[j][i][e] = d; sq += d * d; }
                rstd[j] = sq; }
#pragma unroll
            for (int o = 32; o >= 1; o >>= 1)
#pragma unroll
                for (int j = 0; j < LNR; ++j) rstd[j] += __shfl_xor(rstd[j], o, 64);
#pragma unroll
            for (int j = 0; j < LNR; ++j) rstd[j] = 1.f / sqrtf(rstd[j] * (1.f / 1024.f) + LN_EPS);
        }
        const bool grouped = true;
        const int sset = (r0 >= TL) ? 8 : (r0 >> 13);
#pragma unroll
        for (int i = 0; i < 2; ++i) {
            f32x8 gg, bb, ma, mc;
            if (MODE != 0) { gg = ld8f(g + i * 512 + c0); bb = ld8f(bt + i * 512 + c0); }
            if (MODE != 2) { const float* sh = mods_l + (size_t)sset * NMOD + (3 * sub) * DM + i * 512 + c0; ma = ld8f(sh); mc = ld8f(sh + DM) + 1.f; }
#pragma unroll
            for (int j = 0; j < LNR; ++j) {
                if (!ok[j]) continue;
                const int r = rr[j];
                f32x8 x = v[j][i];
                if (MODE != 0) x = x * rstd[j] * gg + bb;
                if (MODE == 2) { float* o = outf + (size_t)r * DM + i * 512 + c0;
                    *(f32x4*)o = (f32x4){x[0], x[1], x[2], x[3]}; *(f32x4*)(o + 4) = (f32x4){x[4], x[5], x[6], x[7]};
                } else {
                    if (MODE == 0) { h16x8 t;
#pragma unroll
                        for (int e = 0; e < 8; ++e) t[e] = (_Float16)x[e];
                        *(h16x8*)(X + (size_t)r * DM + i * 512 + c0) = t; }
                    if (i == 0 && lane == 0) *(float2*)(stats + (size_t)r * 2) = make_float2(mean[j], rstd[j]);
                    if (!grouped) { const int s2 = (r >= TL) ? 8 : (r >> 13); const float* sh = mods_l + (size_t)s2 * NMOD + (3 * sub) * DM + i * 512 + c0; ma = ld8f(sh); mc = ld8f(sh + DM) + 1.f; }
                    const f32x8 hv = x * mc + ma; u32x4 o; o[0] = pk_bf16(hv[0], hv[1]); o[1] = pk_bf16(hv[2], hv[3]); o[2] = pk_bf16(hv[4], hv[5]); o[3] = pk_bf16(hv[6], hv[7]);
                    *(u32x4*)(h + (size_t)r * DM + i * 512 + c0) = o;
                }
            }
        }
    }
}

template <bool APPLY>
__device__ __forceinline__ void lru_pass(int l, unsigned char* shm) {
    const Params p = kparams();
    const int tid = opaque_tid(), dir = tid >> 8, ch = tid & 255;
    const int w = tid >> 6, lane = tid & 63, fr = lane & 15, fq = lane >> 4, hd = w & 3;
    const u16* P = (const u16*)(p.ws + OFF_P);
    u16* O = (u16*)(p.ws + OFF_O);
    float2* sums = (float2*)(p.ws + OFF_LRU);
    constexpr int AP = 260, XP = 264;
    u16* xraw = (u16*)shm;
    float* Aa = (float*)shm;
    float* Bb = (float*)(shm + 2 * 32 * AP * 4);
    u16* xcb = (u16*)(shm + 4 * 32 * AP * 4);
    bf16x8 wfr[2][4][2];
#pragma unroll
    for (int gt = 0; gt < 2; ++gt) { const u16* lw = (const u16*)(p.ws + OFF_LW) + ((size_t)(((l * 2 + dir) * 2 + gt) * 4 + hd)) * 4096;
#pragma unroll
        for (int nt = 0; nt < 4; ++nt)
#pragma unroll
            for (int ks = 0; ks < 2; ++ks) wfr[gt][nt][ks] = *(const bf16x8*)(lw + (nt * 16 + fr) * 64 + ks * 32 + fq * 8); }
    float ba4[4], bx4[4], sp4[4];
#pragma unroll
    for (int nt = 0; nt < 4; ++nt) { const int c = (l * 2 + dir) * 256 + hd * 64 + nt * 16 + fr; ba4[nt] = p.in[20][c] * -1.4426950408889634f; bx4[nt] = p.in[22][c] * -1.4426950408889634f;
        sp4[nt] = -8.f * 1.4426950408889634f * log1pf(expf(-p.in[23][c])); }
    float cw[4];
#pragma unroll
    for (int t = 0; t < 4; ++t) cw[t] = p.in[17][(l * 4 + t) * 256 + ch];
    const float cb = p.in[18][l * 256 + ch];
#define LRU_LOAD_XRAW(ITEM, DST) do { const int _b = (ITEM) / 264, _q = (ITEM) % 264; const bool _c = _q < 8; \
        const int _pos0 = _c ? _q * 32 : (_q - 8) * 32, _nseq = _c ? CTXL : SEQ, _tok0 = _c ? TL + _b * CTXL : _b * SEQ; \
        _Pragma("unroll") for (int _k = 0; _k < 3; ++_k) { const int _i = tid + NTHREADS * _k; u32x4 _v = {0u, 0u, 0u, 0u}; \
            if (_i < 35 * 32) { const int _rr = _i >> 5, _c8 = (_i & 31) * 8, _pos = _pos0 - 2 + _rr; \
                if (_pos >= 0 && _pos < _nseq) _v = *(const u32x4*)(P + (size_t)(_tok0 + _pos) * NIN + 1536 + _c8); } \
            DST[_k] = _v; } } while (0)
    u32x4 xnext[3];
    if (!APPLY && (int)blockIdx.x < NB * 264) LRU_LOAD_XRAW((int)blockIdx.x, xnext);
    for (int item = blockIdx.x; item < NB * 264; item += gridDim.x) {
        const int b = item / 264, q = item % 264;
        const bool isctx = q < 8;
        const int pos0 = isctx ? q * 32 : (q - 8) * 32, tok0 = isctx ? TL + b * CTXL : b * SEQ;
        if (APPLY) LRU_LOAD_XRAW(item, xnext);
#pragma unroll
        for (int k = 0; k < 3; ++k) { const int i = tid + NTHREADS * k; if (i < 35 * 32) *(u32x4*)(xraw + (i >> 5) * 256 + (i & 31) * 8) = xnext[k]; }
        __syncthreads();
        if (!APPLY && item + (int)gridDim.x < NB * 264) LRU_LOAD_XRAW(item + (int)gridDim.x, xnext);
#pragma unroll 4
        for (int i = 0; i < 16; ++i) { const int pp = dir + 2 * i; float a = cb;
#pragma unroll
            for (int t = 0; t < 4; ++t) a += cw[t] * bf2f(xraw[(pp + t) * 256 + ch]);
            xcb[pp * XP + ch] = f2bf(a); }
        __syncthreads();
        {
            bf16x8 xa[2][2];
#pragma unroll
            for (int pt = 0; pt < 2; ++pt)
#pragma unroll
                for (int ks = 0; ks < 2; ++ks) xa[pt][ks] = *(const bf16x8*)(xcb + (pt * 16 + fr) * XP + hd * 64 + ks * 32 + fq * 8);
#pragma unroll
            for (int pt = 0; pt < 2; ++pt)
#pragma unroll
                for (int nt = 0; nt < 4; ++nt) {
                    f32x4 pa = {0.f, 0.f, 0.f, 0.f}, pi = {0.f, 0.f, 0.f, 0.f};
#pragma unroll
                    for (int ks = 0; ks < 2; ++ks) { pa = __builtin_amdgcn_mfma_f32_16x16x32_bf16(xa[pt][ks], wfr[0][nt][ks], pa, 0, 0, 0); pi = __builtin_amdgcn_mfma_f32_16x16x32_bf16(xa[pt][ks], wfr[1][nt][ks], pi, 0, 0, 0); }
                    const int chn = hd * 64 + nt * 16 + fr;
#pragma unroll
                    for (int j2 = 0; j2 < 2; ++j2) {
                        typedef float f32x2 __attribute__((ext_vector_type(2)));
                        const int pos = pt * 16 + fq * 4 + 2 * j2;
                        const f32x2 za = (f32x2){pa[2 * j2], pa[2 * j2 + 1]} * -1.4426950408889634f + ba4[nt];
                        const f32x2 zi = (f32x2){pi[2 * j2], pi[2 * j2 + 1]} * -1.4426950408889634f + bx4[nt];
                        const f32x2 da = (f32x2){__builtin_amdgcn_exp2f(za[0]), __builtin_amdgcn_exp2f(za[1])} + 1.f;
                        const f32x2 di = (f32x2){__builtin_amdgcn_exp2f(zi[0]), __builtin_amdgcn_exp2f(zi[1])} + 1.f;
                        const f32x2 rg = (f32x2){__builtin_amdgcn_rcpf(da[0]), __builtin_amdgcn_rcpf(da[1])};
                        const f32x2 ig = (f32x2){__builtin_amdgcn_rcpf(di[0]), __builtin_amdgcn_rcpf(di[1])};
                        const f32x2 e2 = rg * sp4[nt];
                        const f32x2 a = (f32x2){__builtin_amdgcn_exp2f(e2[0]), __builtin_amdgcn_exp2f(e2[1])};
                        const f32x2 t2 = e2 * 1.3862943611198906f;
                        f32x2 q = t2 * 0.0083333333f + 0.041666667f; q = q * t2 + 0.16666667f; q = q * t2 + 0.5f; q = q * t2 + 1.f;
                        const f32x2 omp = -t2 * q;
                        const f32x2 omd = 1.f - a * a;
                        const f32x2 om = (f32x2){t2[0] > -0.25f ? omp[0] : omd[0], t2[1] > -0.25f ? omp[1] : omd[1]};
                        const f32x2 xv = (f32x2){bf2f(xcb[pos * XP + chn]), bf2f(xcb[(pos + 1) * XP + chn])};
                        const f32x2 bt = (f32x2){__builtin_amdgcn_sqrtf(om[0]), __builtin_amdgcn_sqrtf(om[1])} * (ig * xv);
                        Aa[(dir * 32 + pos) * AP + chn] = a[0]; Aa[(dir * 32 + pos + 1) * AP + chn] = a[1];
                        Bb[(dir * 32 + pos) * AP + chn] = bt[0]; Bb[(dir * 32 + pos + 1) * AP + chn] = bt[1]; }
                    __builtin_amdgcn_sched_barrier(0);
                }
        }
        float hcar = 0.f; u16 grv[16];
        if (APPLY) {
            hcar = ((const float*)(p.ws + OFF_CAR))[((size_t)(b * 264 + q) * 2 + dir) * 256 + ch];
#pragma unroll
            for (int i = 0; i < 16; ++i) grv[i] = P[(size_t)(tok0 + pos0 + dir + 2 * i) * NIN + 1792 + ch];
        }
        __syncthreads();
        float h = 0.f, A = 1.f;
        if (APPLY) h = hcar;
#pragma unroll 8
        for (int st = 0; st < 32; ++st) { const int pp = dir ? 31 - st : st; const float a = Aa[(dir * 32 + pp) * AP + ch], bt = Bb[(dir * 32 + pp) * AP + ch];
            h = a * h + bt; A *= a; if (APPLY) Bb[(dir * 32 + pp) * AP + ch] = h;
            if (!APPLY) {
                unsigned char* prow = (unsigned char*)(p.ws + OFF_P) + (size_t)(tok0 + pos0 + pp) * (NIN * 2);
                *(_Float16*)(prow + 2048 + (dir * 256 + ch) * 2) = (_Float16)h;
                prow[4096 + dir * 256 + ch] = (unsigned char)(A * 255.f + 0.5f); } }
        if (!APPLY) { sums[((size_t)(b * 264 + q) * 2 + dir) * 256 + ch] = make_float2(A, h); }
        else {
            __syncthreads();
#pragma unroll
            for (int i = 0; i < 16; ++i) { const int pp = dir + 2 * i; const size_t tok = (size_t)(tok0 + pos0 + pp);
                const float gr = bf2f(grv[i]);
                O[tok * KOUT + 512 + ch] = f2bf((Bb[pp * AP + ch] + Bb[(32 + pp) * AP + ch]) * gelu_tanh(gr)); }
        }
        __syncthreads();
    }
}

#undef LRU_LOAD_XRAW
typedef unsigned char u8x8 __attribute__((ext_vector_type(8)));
__device__ __forceinline__ void lru_apply() {
    const Params p = kparams();
    const int tid = opaque_tid();
    const unsigned char* Pb = (const unsigned char*)(p.ws + OFF_P);
    u16* O = (u16*)(p.ws + OFF_O);
    const float* car = (const float*)(p.ws + OFF_CAR);
    for (int item = blockIdx.x; item < NB * 264; item += gridDim.x) {
        const int b = item / 264, q = item % 264;
        const bool isctx = q < 8;
        const int pos0 = isctx ? q * 32 : (q - 8) * 32, tok0 = isctx ? TL + b * CTXL : b * SEQ;
        const int ch0 = (tid & 31) * 8;
        const float* cf = car + ((size_t)(b * 264 + q) * 2) * 256 + ch0;
        const f32x8 carF = ld8f(cf), carR = ld8f(cf + 256);
#pragma unroll
        for (int u = 0; u < 2; ++u) {
            const int pos = (tid >> 5) + 16 * u;
            const unsigned char* prow = Pb + (size_t)(tok0 + pos0 + pos) * (NIN * 2);
            const h16x8 hf = *(const h16x8*)(prow + 2048 + ch0 * 2), hr = *(const h16x8*)(prow + 2048 + (256 + ch0) * 2);
            const u8x8 af = *(const u8x8*)(prow + 4096 + ch0), ar = *(const u8x8*)(prow + 4096 + 256 + ch0);
            const bf16x8 gr = *(const bf16x8*)(prow + (1792 + ch0) * 2);
            float o[8];
#pragma unroll
            for (int e = 0; e < 8; ++e) { const float hsum = (float)hf[e] + (float)hr[e] + ((float)af[e] * carF[e] + (float)ar[e] * carR[e]) * (1.f / 255.f);
                o[e] = hsum * gelu_tanh(bf2f((u16)gr[e])); }
            u32x4 ov; ov[0] = pk_bf16(o[0], o[1]); ov[1] = pk_bf16(o[2], o[3]); ov[2] = pk_bf16(o[4], o[5]); ov[3] = pk_bf16(o[6], o[7]);
            *(u32x4*)(O + (size_t)(tok0 + pos0 + pos) * KOUT + 512 + ch0) = ov;
        }
    }
}

__device__ __forceinline__ void lru_prefix() {
    const Params p = kparams();
    const int tid = opaque_tid();
    const int chain = blockIdx.x * NTHREADS + tid;
    if (chain >= NB * 512) return;
    const int b = chain >> 9, dir = (chain >> 8) & 1, ch = chain & 255;
    const float2* sb = (const float2*)(p.ws + OFF_LRU) + ((size_t)b * 264 * 2 + dir) * 256 + ch;
    float* cb = (float*)(p.ws + OFF_CAR) + ((size_t)b * 264 * 2 + dir) * 256 + ch;
    float h = 0.f;
    for (int i0 = 0; i0 < 264; i0 += 8) {
        float2 ab[8]; int qq[8];
#pragma unroll
        for (int j = 0; j < 8; ++j) { const int i = i0 + j; qq[j] = dir ? (i < 8 ? 7 - i : 271 - i) : i; ab[j] = sb[(size_t)qq[j] * 512]; }
#pragma unroll
        for (int j = 0; j < 8; ++j) { cb[(size_t)qq[j] * 512] = h; h = ab[j].x * h + ab[j].y; }
    }
}

__device__ __forceinline__ void ft_fold() {
    const Params p = kparams();
    const int tid = opaque_tid();
    const u16* Ft = (const u16*)(p.ws + OFF_FT);
    u16* GE = (u16*)(p.ws + OFF_GE); u16* GO = (u16*)(p.ws + OFF_GO);
    const int nvec = NB * 64 * 256 * 8;
    for (int v = blockIdx.x * NTHREADS + tid; v < nvec; v += gridDim.x * NTHREADS) {
        const int b = v >> 17, rem = v & 131071;
        const size_t src = ((size_t)b * 128 * 256 * 64) + (size_t)rem * 8;
        const bf16x8 lo = *(const bf16x8*)(Ft + src), hi = *(const bf16x8*)(Ft + src + (size_t)64 * 256 * 64);
        u32x4 e, o;
#pragma unroll
        for (int j = 0; j < 4; ++j) { const float a0 = bf2f((u16)lo[2 * j]), a1 = bf2f((u16)lo[2 * j + 1]), b0 = bf2f((u16)hi[2 * j]), b1 = bf2f((u16)hi[2 * j + 1]);
            e[j] = pk_bf16(a0 + b0, a1 + b1); o[j] = pk_bf16(a0 - b0, a1 - b1); }
        *(u32x4*)(GE + (size_t)v * 8) = e; *(u32x4*)(GO + (size_t)v * 8) = o;
    }
}

__device__ __forceinline__ void attn_phase(int l, unsigned char* shm) {
    const Params p = kparams();
    const int tid = opaque_tid(), w = tid >> 6, lane = tid & 63, fr = lane & 15, fq = lane >> 4;
    const u16* P = (const u16*)(p.ws + OFF_P);
    const u16* Vt = (const u16*)(p.ws + OFF_VT);
    u16* O = (u16*)(p.ws + OFF_O);
    constexpr int KP = 72, VP = 264;
    u16* Kc = (u16*)shm;
    u16* Vc = (u16*)(shm + 256 * KP * 2);
    float* rp = (float*)(shm + 256 * KP * 2 + 64 * VP * 2);
    const float NEG = -__builtin_huge_valf();
    const int krow = 8 * (fr >> 2) + (fr & 3);
    for (int combo = blockIdx.x; combo < NB * 8 * 4; combo += gridDim.x) {
        const int xj = combo >> 3, ph = (xj >> 2) * 8 + (combo & 7), b = ph >> 3, hh = ph & 7, qr = xj & 3;
        __syncthreads();
        { const int row = tid >> 1, half = tid & 1; const u16* src = P + (size_t)(TL + b * CTXL + row) * NIN + 512 + hh * 64 + half * 32; u16* dst = Kc + row * KP + half * 32;
#pragma unroll
          for (int i = 0; i < 4; ++i) *(u32x4*)(dst + i * 8) = *(const u32x4*)(src + i * 8); }
        { const int d = tid >> 3, seg = tid & 7; const u16* src = (const u16*)(p.ws + OFF_VTC) + ((size_t)((b * 8 + hh) * 64 + d)) * CTXL + seg * 32; u16* dst = Vc + d * VP + seg * 32;
#pragma unroll
          for (int i = 0; i < 4; ++i) *(u32x4*)(dst + i * 8) = *(const u32x4*)(src + i * 8); }
        for (int i = tid; i < 465; i += NTHREADS) rp[i] = p.in[16][(size_t)l * 3720 + hh * 465 + i];
        __syncthreads();
        const int nsteps = (l == DEPTH - 1) ? 16 : 17;
        for (int it = 0; it < nsteps; ++it) {
            bool local; int r = 0, jb = 0, qtok0;
            if (it < 16) { const int i = it * 8 + w; local = true; r = qr * 32 + (i >> 2); jb = i & 3; qtok0 = b * SEQ + r * 64 + jb * 16; }
            else { if (w >= 4) continue; local = false; qtok0 = TL + b * CTXL + (qr * 4 + w) * 16; }
            const int rs = min(max(r - 4, 0), 120);
            const int cstart = jb == 0 ? 0 : (jb == 1 ? 8 : (jb == 2 ? 24 : 32));
            bf16x8 qf[2];
#pragma unroll
            for (int ks = 0; ks < 2; ++ks) qf[ks] = *(const bf16x8*)(P + (size_t)(qtok0 + fr) * NIN + hh * 64 + ks * 32 + fq * 8);
            f32x4 sl[16], sc[16];
            float mx = NEG;
            bf16x8 vl[2][4];
            if (local) {
                const int qc = jb * 16 + fr, col0 = min(max(qc - 8, 0), 48);
                const int kcb = cstart + 8 * fq - col0;
                const float* rpl = rp + (cstart + 8 * fq - qc + 15) + (rs - r + 7) * 31;
                const u16* kbase = P + ((size_t)b * SEQ + rs * 64 + cstart + krow) * NIN + 512 + hh * 64 + fq * 8;
#pragma unroll
                for (int hf = 0; hf < 2; ++hf) {
                    bf16x8 kf[4][2][2];
#pragma unroll
                    for (int i4 = 0; i4 < 4; ++i4)
#pragma unroll
                        for (int o = 0; o < 2; ++o) { const u16* kp = kbase + (size_t)((hf * 4 + i4) * 64 + 4 * o) * NIN; kf[i4][o][0] = *(const bf16x8*)kp; kf[i4][o][1] = *(const bf16x8*)(kp + 32); }
                    __builtin_amdgcn_sched_barrier(0);
#pragma unroll
                    for (int i4 = 0; i4 < 4; ++i4)
#pragma unroll
                        for (int o = 0; o < 2; ++o) { const int i = hf * 4 + i4;
                            f32x4 a = {0.f, 0.f, 0.f, 0.f};
                            a = __builtin_amdgcn_mfma_f32_16x16x32_bf16(kf[i4][o][0], qf[0], a, 0, 0, 0);
                            a = __builtin_amdgcn_mfma_f32_16x16x32_bf16(kf[i4][o][1], qf[1], a, 0, 0, 0);
#pragma unroll
                            for (int j = 0; j < 4; ++j) { const bool valid = (unsigned)(kcb + 4 * o + j) < 16u;
                                const float sv = valid ? a[j] + rpl[i * 31 + 4 * o + j] : NEG; a[j] = sv; mx = fmaxf(mx, sv); }
                            sl[i * 2 + o] = a; }
                    __builtin_amdgcn_sched_barrier(0);
                }
#pragma unroll
                for (int t = 0; t < 2; ++t)
#pragma unroll
                    for (int db = 0; db < 4; ++db) vl[t][db] = *(const bf16x8*)(Vt + ((size_t)((b * 8 + hh) * 64 + db * 16 + fr)) * VTP + (rs + t) * 64 + cstart + 8 * fq);
                __builtin_amdgcn_sched_barrier(0);
            } else {
#pragma unroll
                for (int i = 0; i < 16; ++i) sl[i] = (f32x4){NEG, NEG, NEG, NEG};
            }
#pragma unroll
            for (int t = 0; t < 8; ++t)
#pragma unroll
                for (int o = 0; o < 2; ++o) {
                    const u16* kp = Kc + (32 * t + krow + 4 * o) * KP + fq * 8;
                    const bf16x8 k0 = *(const bf16x8*)kp, k1 = *(const bf16x8*)(kp + 32);
                    f32x4 a = {0.f, 0.f, 0.f, 0.f};
                    a = __builtin_amdgcn_mfma_f32_16x16x32_bf16(k0, qf[0], a, 0, 0, 0);
                    a = __builtin_amdgcn_mfma_f32_16x16x32_bf16(k1, qf[1], a, 0, 0, 0);
                    sc[2 * t + o] = a; mx = fmaxf(mx, fmaxf(fmaxf(a[0], a[1]), fmaxf(a[2], a[3])));
                }
            mx = fmaxf(mx, __shfl_xor(mx, 16, 64)); mx = fmaxf(mx, __shfl_xor(mx, 32, 64));
            float sum = 0.f; const float nmx = -mx * 1.4426950408889634f;
#pragma unroll
            for (int i = 0; i < 16; ++i) {
#pragma unroll
                for (int j = 0; j < 4; ++j) { const float e0 = __builtin_amdgcn_exp2f(fmaf(sl[i][j], 1.4426950408889634f, nmx)), e1 = __builtin_amdgcn_exp2f(fmaf(sc[i][j], 1.4426950408889634f, nmx)); sl[i][j] = e0; sc[i][j] = e1; sum += e0 + e1; } }
            sum += __shfl_xor(sum, 16, 64); sum += __shfl_xor(sum, 32, 64);
            f32x4 oa[4];
#pragma unroll
            for (int db = 0; db < 4; ++db) oa[db] = (f32x4){0.f, 0.f, 0.f, 0.f};
#pragma unroll
            for (int bt = 0; bt < 4; ++bt) {
                if (local) {
#pragma unroll
                    for (int t2 = 0; t2 < 2; ++t2) { const int t = bt * 2 + t2;
                        u32x4 pf; pf[0] = pk_bf16(sl[2 * t][0], sl[2 * t][1]); pf[1] = pk_bf16(sl[2 * t][2], sl[2 * t][3]); pf[2] = pk_bf16(sl[2 * t + 1][0], sl[2 * t + 1][1]); pf[3] = pk_bf16(sl[2 * t + 1][2], sl[2 * t + 1][3]);
                        const bf16x8 pa = __builtin_bit_cast(bf16x8, pf);
#pragma unroll
                        for (int db = 0; db < 4; ++db) oa[db] = __builtin_amdgcn_mfma_f32_16x16x32_bf16(pa, vl[t2][db], oa[db], 0, 0, 0); }
                    __builtin_amdgcn_sched_barrier(0);
                    if (bt < 3) {
#pragma unroll
                        for (int t2 = 0; t2 < 2; ++t2)
#pragma unroll
                            for (int db = 0; db < 4; ++db) vl[t2][db] = *(const bf16x8*)(Vt + ((size_t)((b * 8 + hh) * 64 + db * 16 + fr)) * VTP + (rs + bt * 2 + 2 + t2) * 64 + cstart + 8 * fq);
                        __builtin_amdgcn_sched_barrier(0);
                    }
                }
#pragma unroll
                for (int t2 = 0; t2 < 2; ++t2) { const int t = bt * 2 + t2;
                    u32x4 pf; pf[0] = pk_bf16(sc[2 * t][0], sc[2 * t][1]); pf[1] = pk_bf16(sc[2 * t][2], sc[2 * t][3]); pf[2] = pk_bf16(sc[2 * t + 1][0], sc[2 * t + 1][1]); pf[3] = pk_bf16(sc[2 * t + 1][2], sc[2 * t + 1][3]);
                    const bf16x8 pa = __builtin_bit_cast(bf16x8, pf);
#pragma unroll
                    for (int db = 0; db < 4; ++db) {
                        const bf16x8 vv = *(const bf16x8*)(Vc + (db * 16 + fr) * VP + 32 * t + 8 * fq);
                        oa[db] = __builtin_amdgcn_mfma_f32_16x16x32_bf16(pa, vv, oa[db], 0, 0, 0);
                    } }
                __builtin_amdgcn_sched_barrier(0);
            }
            const float inv = 1.f / sum;
            u16* ot = (u16*)(shm + 256 * KP * 2 + 64 * VP * 2 + 2048) + w * (16 * 72);
#pragma unroll
            for (int j = 0; j < 4; ++j) { const float iv = __shfl(inv, fq * 4 + j, 64);
#pragma unroll
                for (int db = 0; db < 4; ++db) ot[(fq * 4 + j) * 72 + db * 16 + fr] = f2bf(oa[db][j] * iv); }
            __builtin_amdgcn_wave_barrier();
            { const int qq = lane >> 2, sg = (lane & 3) * 16;
              const u32x4 o0 = *(const u32x4*)(ot + qq * 72 + sg), o1 = *(const u32x4*)(ot + qq * 72 + sg + 8);
              u16* dst = O + (size_t)(qtok0 + qq) * KOUT + hh * 64 + sg;
              *(u32x4*)dst = o0; *(u32x4*)(dst + 8) = o1; }
            __builtin_amdgcn_wave_barrier();
        }
    }
    __syncthreads();
}

#define XB_TMO      128
#define XB_XCNT(j)  (256  + 64 * (j))
#define XB_XSUB(j)  (1280 + 64 * (j))
#define XB_XGEN(j)  (2304 + 64 * (j))
#define XB_TOP      3328
#define XB_TOPGEN   3392
#define XB_SPIN_CAP (1u << 18)
__device__ __forceinline__ unsigned xb_ld(unsigned* p)              { return __hip_atomic_load(p, __ATOMIC_RELAXED, __HIP_MEMORY_SCOPE_AGENT); }
__device__ __forceinline__ unsigned xb_add(unsigned* p, unsigned v) { return __hip_atomic_fetch_add(p, v, __ATOMIC_RELAXED, __HIP_MEMORY_SCOPE_AGENT); }
__device__ __forceinline__ unsigned xb_xcc_id() { return (unsigned)__builtin_amdgcn_s_getreg((3 << 11) | 20) & 0xFu; }
#define XB_SPIN(cond, bar) do { unsigned _sp = 0; while (cond) { \
    if ((++_sp & 255u) == 0u) { if (xb_ld(&(bar)[XB_TMO])) break; if (_sp > XB_SPIN_CAP) { atomicAdd(&(bar)[XB_TMO], 1u); break; } } } } while (0)
__device__ __forceinline__ void xcd_barrier_complete(unsigned* bar, unsigned x, unsigned& nloc, unsigned& nx) {
    const unsigned G = gridDim.x * gridDim.y * gridDim.z;
    unsigned sum, cnt, mine, sp = 0u;
    for (;;) {
        sum = 0u; cnt = 0u; mine = 0u;
#pragma unroll
        for (unsigned j = 0; j < 16; ++j) { const unsigned c = xb_ld(&bar[XB_XCNT(j)]); sum += c; cnt += (c > 0u) ? 1u : 0u; mine = (j == x) ? c : mine; }
        if (sum == G) break;
        __builtin_amdgcn_s_sleep(1);
        if ((++sp & 255u) == 0u) { if (xb_ld(&bar[XB_TMO])) break; if (sp > XB_SPIN_CAP) { atomicAdd(&bar[XB_TMO], 1u); break; } }
    }
    nloc = mine > 0u ? mine : 1u; nx = cnt > 0u ? cnt : 1u;
}
__device__ __forceinline__ void xcd_barrier(volatile unsigned* st) {
    asm volatile("s_waitcnt vmcnt(0)" ::: "memory");
    __syncthreads();
    const Params p = kparams();
    unsigned* bar = (unsigned*)(p.ws + OFF_BAR);
    if (threadIdx.x == 0) {
        const unsigned x = xb_xcc_id();
        __builtin_amdgcn_s_waitcnt(0);
        unsigned nloc = st[0], nx = st[1];
        if (nloc == 0u) { xcd_barrier_complete(bar, x, nloc, nx); st[0] = nloc; st[1] = nx; }
        const unsigned old = xb_add(&bar[XB_XSUB(x)], 1u);
        const unsigned gen = old / nloc;
        if (old + 1u == (gen + 1u) * nloc) {
            __builtin_amdgcn_fence(__ATOMIC_RELEASE, "agent");
            asm volatile("s_waitcnt vmcnt(0)" ::: "memory");
            const unsigned og = xb_add(&bar[XB_TOP], 1u);
            const unsigned tg = og / nx;
            if (og + 1u == (tg + 1u) * nx) xb_add(&bar[XB_TOPGEN], 1u);
            else XB_SPIN(xb_ld(&bar[XB_TOPGEN]) == tg, bar);
            __builtin_amdgcn_fence(__ATOMIC_ACQUIRE, "agent");
            xb_add(&bar[XB_XGEN(x)], 1u);
            asm volatile("s_waitcnt vmcnt(0)" ::: "memory");
        } else {
            XB_SPIN(xb_ld(&bar[XB_XGEN(x)]) == gen, bar);
            __builtin_amdgcn_fence(__ATOMIC_ACQUIRE, "agent");
            asm volatile("s_waitcnt vmcnt(0)" ::: "memory");
        }
    }
    __syncthreads();
}

__global__ __launch_bounds__(NTHREADS, 2) void fwd_kernel(Params pk) {
    extern __shared__ __attribute__((aligned(16))) unsigned char shm[];
    cg::grid_group grid = cg::this_grid();
    LAS unsigned char* lds = (LAS unsigned char*)shm;
    volatile unsigned* xst = (volatile unsigned*)(shm + 150528);
    { const Params p = kparams(); unsigned* bar = (unsigned*)(p.ws + OFF_BAR);
      if (threadIdx.x == 0) { xst[0] = 0u; xst[1] = 0u; (void)xb_add(&bar[XB_XCNT(xb_xcc_id())], 1u); } }
    __syncthreads();
    phase0(shm);
    grid.sync();
    { const Params p = kparams(); ln_phase<0>(p.in[0], p.in[2], (_Float16*)(p.ws + OFF_X16), (float*)(p.ws + OFF_ST), nullptr, (u16*)(p.ws + OFF_O), nullptr, nullptr, (const float*)(p.ws + OFF_MOD), 0, TT); }
    for (int l = 0; l < DEPTH; ++l) {
        for (int st = 0; st < 3; ++st) {
            const int rows = (l == DEPTH - 1 && st == 2) ? TL : TT;
            if (st != 1) {
                const int f = st >> 1;
                xcd_barrier(xst);
                { const Params p = kparams(); const u16* wl = (const u16*)(p.ws + OFF_W) + (size_t)l * W_LAYER;
                  pg8::Gemm g{(const u16*)(p.ws + OFF_O), wl + (f ? W_GU2 : W_GU1), rows, 2 * DFF, DM, 0, 0, 0, 0, 0, nullptr, 0}; EpiGU e{(u16*)(p.ws + OFF_H)}; pg8::gemm_phase(lds, g, e); }
                xcd_barrier(xst);
                const bool split = (rows == TT);
#pragma nounroll
                for (int part = 0; part < 2; ++part) {
                    if (part == 1) { if (!split) break; xcd_barrier(xst); }
                    { const Params p = kparams(); const u16* wl = (const u16*)(p.ws + OFF_W) + (size_t)l * W_LAYER;
                      pg8::Gemm g{(const u16*)(p.ws + OFF_H), wl + (f ? W_D2 : W_D1), rows, DM, DFF, 0, 1, 0, part ? 1024 : 0, part ? 32 : 1024, nullptr, 0};
                      const int pl = l * 3 + st - 1;
                      const float* lg = pl < 0 ? (const float*)(p.ws + OFF_ID) : p.in[6] + (size_t)pl * DM; const float* lb = pl < 0 ? (const float*)(p.ws + OFF_ID) + DM : p.in[7] + (size_t)pl * DM;
                      EpiRes e{(_Float16*)(p.ws + OFF_X16), (const float*)(p.ws + OFF_ST), lg, lb, (const float*)(p.ws + OFF_MOD) + (size_t)l * 9 * NMOD, 3 * st + 2, 0.5f}; pg8::gemm_phase(lds, g, e); }
                    if (part == 1) { const Params p = kparams(); const int nl = (st == 2) ? l + 1 : l, nsub = (st == 2) ? 0 : 1;
                        ln_phase<1>(nullptr, nullptr, (_Float16*)(p.ws + OFF_X16), (float*)(p.ws + OFF_ST), nullptr, (u16*)(p.ws + OFF_O), p.in[6] + (size_t)(l * 3 + st) * DM, p.in[7] + (size_t)(l * 3 + st) * DM,
                                    (const float*)(p.ws + OFF_MOD) + (size_t)nl * 9 * NMOD, nsub, TL, 0, 32); }
                }
                xcd_barrier(xst);
                { const Params p = kparams();
                  const float* gg = p.in[6] + (size_t)(l * 3 + st) * DM; const float* bb = p.in[7] + (size_t)(l * 3 + st) * DM;
                  if (!split) ln_phase<2>(nullptr, nullptr, (_Float16*)(p.ws + OFF_X16), nullptr, p.out, nullptr, gg, bb, nullptr, 0, TL);
                  else { const int nl = (st == 2) ? l + 1 : l, nsub = (st == 2) ? 0 : 1;
                         ln_phase<1>(nullptr, nullptr, (_Float16*)(p.ws + OFF_X16), (float*)(p.ws + OFF_ST), nullptr, (u16*)(p.ws + OFF_O), gg, bb, (const float*)(p.ws + OFF_MOD) + (size_t)nl * 9 * NMOD, nsub, TT, TL, 0); } }
            } else {
                const int orows = (l == DEPTH - 1) ? TL : TT;
                xcd_barrier(xst);
                { const Params p = kparams(); const u16* wl = (const u16*)(p.ws + OFF_W) + (size_t)l * W_LAYER;
                  pg8::Gemm g{(const u16*)(p.ws + OFF_O), wl + W_IN, TT, NIN, DM, 0, 0, 0, 0, 0, nullptr, 0}; EpiIn e{(u16*)(p.ws + OFF_P), (u16*)(p.ws + OFF_VT), (u16*)(p.ws + OFF_VTC), (u16*)(p.ws + OFF_FT), (u16*)(p.ws + OFF_FTC)}; pg8::gemm_phase(lds, g, e); }
                xcd_barrier(xst);
                ft_fold();
                lru_pass<false>(l, shm);
                xcd_barrier(xst);
                lru_prefix();
#pragma nounroll
                for (int wh = 0; wh < ((l == DEPTH - 1) ? 1 : 2); ++wh) { const Params p = kparams();
                  pg8::Gemm g{(const u16*)(p.ws + (wh ? OFF_DFTC : OFF_DFT)), (const u16*)(p.ws + (wh ? OFF_FTC : OFF_GE)), wh ? 256 : 8192, NB * 256, wh ? CTXL : 4096, 0, wh ? 0 : 1, wh ? 0 : 1, 0, 0,
                              wh ? (const u16*)nullptr : (const u16*)(p.ws + OFF_GO), 16};
                  EpiDft e{(u16*)(p.ws + OFF_O), wh ? TL : 0, wh ? 7 : 12, wh ? CTXL : SEQ, wh ? 0 : 1}; pg8::gemm_phase(lds, g, e); }
                xcd_barrier(xst);
                lru_apply();
                attn_phase(l, shm);
                xcd_barrier(xst);
                const bool osplit = (orows == TT);
#pragma nounroll
                for (int part = 0; part < 2; ++part) {
                    if (part == 1) { if (!osplit) break; xcd_barrier(xst); }
                    { const Params p = kparams(); const u16* wl = (const u16*)(p.ws + OFF_W) + (size_t)l * W_LAYER;
                      pg8::Gemm g{(const u16*)(p.ws + OFF_O), wl + W_OUT, orows, DM, KOUT, 0, 0, 0, part ? 1024 : 0, part ? 32 : 1024, nullptr, 0};
                      EpiRes e{(_Float16*)(p.ws + OFF_X16), (const float*)(p.ws + OFF_ST), p.in[6] + (size_t)(l * 3) * DM, p.in[7] + (size_t)(l * 3) * DM, (const float*)(p.ws + OFF_MOD) + (size_t)l * 9 * NMOD, 5, 1.0f}; pg8::gemm_phase(lds, g, e); }
                    if (part == 1) { const Params p = kparams();
                        ln_phase<1>(nullptr, nullptr, (_Float16*)(p.ws + OFF_X16), (float*)(p.ws + OFF_ST), nullptr, (u16*)(p.ws + OFF_O), p.in[6] + (size_t)(l * 3 + 1) * DM, p.in[7] + (size_t)(l * 3 + 1) * DM,
                                    (const float*)(p.ws + OFF_MOD) + (size_t)l * 9 * NMOD, 2, TL, 0, 32); }
                }
                xcd_barrier(xst);
                { const Params p = kparams();
                  ln_phase<1>(nullptr, nullptr, (_Float16*)(p.ws + OFF_X16), (float*)(p.ws + OFF_ST), nullptr, (u16*)(p.ws + OFF_O), p.in[6] + (size_t)(l * 3 + 1) * DM, p.in[7] + (size_t)(l * 3 + 1) * DM,
                              (const float*)(p.ws + OFF_MOD) + (size_t)l * 9 * NMOD, 2, orows, osplit ? TL : 0, 0); }
            }
        }
    }
}

extern "C" void kernel_launch(void* const* d_in, const int* in_sizes, int n_in, void* d_out, int out_size, void* d_ws, size_t ws_size, hipStream_t stream) {
    static int grid = 0;
    if (grid == 0) {
        if (n_in != 25 || out_size != TL * DM || ws_size < WS_END) { fprintf(stderr, "kernel_launch: unexpected shapes (n_in %d out %d ws %zu need %zu)\n", n_in, out_size, ws_size, (size_t)WS_END); grid = -1; return; }
        int dev = 0, cus = 0, per_cu = 0;
        hipGetDevice(&dev);
        hipDeviceGetAttribute(&cus, hipDeviceAttributeMultiprocessorCount, dev);
        hipFuncSetAttribute((const void*)fwd_kernel, hipFuncAttributeMaxDynamicSharedMemorySize, LDS_BYTES);
        hipOccupancyMaxActiveBlocksPerMultiprocessor(&per_cu, (const void*)fwd_kernel, NTHREADS, LDS_BYTES);
        if (per_cu < 1) per_cu = 1;
        if (per_cu > 1) per_cu = 1;
        (void)hipGetLastError();
        grid = cus * per_cu;
    }
    if (grid < 0) return;
    if (hipMemsetAsync((char*)d_ws + OFF_BAR, 0, (size_t)XCD_BAR_WORDS * 4, stream) != hipSuccess) { fprintf(stderr, "kernel_launch: memset of the barrier words failed\n"); return; }
    Params p{};
    for (int i = 0; i < 25; ++i) p.in[i] = (const float*)d_in[i];
    p.out = (float*)d_out; p.ws = (unsigned char*)d_ws;
    void* args[] = {&p};
    hipError_t e = hipLaunchCooperativeKernel((const void*)fwd_kernel, dim3(grid), dim3(NTHREADS), args, LDS_BYTES, stream);
    if (e != hipSuccess) fprintf(stderr, "cooperative launch failed: %s (grid %d)\n", hipGetErrorString(e), grid);
}
```
